# Optimizing an MI355X kernel written in HIP

```python
import jax, jax.numpy as jnp
from jax import lax
import numpy as np

D_MODEL = 1024
BATCH = 32
SEQ = 2048
DEPTH = 2

MEM_LEN = 256
HEAD_DIM = 64
N_SB_HEADS = 12
N_MEM_HEADS = 4
DIL_GROUPS = ((128, 1), (512, 4), (2048, 16))
HEADS_PER_GROUP = 4
N_DIL_HEADS = HEADS_PER_GROUP * len(DIL_GROUPS)
SB_WIDTH = N_SB_HEADS * HEAD_DIM
MEM_WIDTH = N_MEM_HEADS * HEAD_DIM
DIL_WIDTH = N_DIL_HEADS * HEAD_DIM
D_FF = 2816
CONV_WIDTH = 3
Q_BLOCK = 128
N_A_LAYERS = DEPTH // 2
N_B_LAYERS = DEPTH - N_A_LAYERS
EPS = 1e-6
ALIBI_MAX_BIAS = 8.0

kernel_name = "yoco_stickbreaking_dilated_hybrid"


def rmsnorm(x, g):
    xf = x.astype(jnp.float32)
    y = xf * lax.rsqrt(jnp.mean(xf * xf, axis=-1, keepdims=True) + EPS)
    return (y * g.astype(jnp.float32)).astype(x.dtype)


def alibi_slopes(n):
    return 2.0 ** (-ALIBI_MAX_BIAS * jnp.arange(1, n + 1, dtype=jnp.float32) / n)


def _heads(t, n_heads):
    return t.reshape(t.shape[0], t.shape[1], n_heads, HEAD_DIM)


def stick_breaking_attention(q, k, v):
    s_len = q.shape[1]
    scale = HEAD_DIM ** -0.5
    outs = []
    for blk in range(s_len // Q_BLOCK):
        q0 = blk * Q_BLOCK
        k_end = q0 + Q_BLOCK
        z = jnp.einsum('bqhd,bkhd->bhqk', q[:, q0:k_end], k[:, :k_end]).astype(jnp.float32) * scale
        t_pos = q0 + jnp.arange(Q_BLOCK)[:, None]
        s_pos = jnp.arange(k_end)[None, :]
        causal = s_pos < t_pos
        log_stay = jnp.where(causal, -jax.nn.softplus(z), 0.0)
        later = lax.cumsum(log_stay, axis=3, reverse=True) - log_stay
        w = jnp.where(causal, jnp.exp(jax.nn.log_sigmoid(z) + later), 0.0)
        outs.append(jnp.einsum('bhqk,bkhd->bqhd', w.astype(v.dtype), v[:, :k_end]))
    return jnp.concatenate(outs, axis=1)


def dilated_window_attention(q, k, v, slopes, window, dilation):
    b, s_len, n_h, dh = q.shape
    w_sub = window // dilation
    blk = w_sub
    L = s_len // dilation
    nb = -(-L // blk)
    Lp = nb * blk

    def by_residue(t):
        return t.reshape(b, L, dilation, n_h, dh).transpose(0, 2, 1, 3, 4)

    qs, ks, vs = by_residue(q), by_residue(k), by_residue(v)
    qb = jnp.pad(qs, ((0, 0), (0, 0), (0, Lp - L), (0, 0), (0, 0))).reshape(b, dilation, nb, blk, n_h, dh)

    def key_blocks(t):
        tp = jnp.pad(t, ((0, 0), (0, 0), (blk, Lp - L), (0, 0), (0, 0)))
        prev = tp[:, :, :Lp].reshape(b, dilation, nb, blk, n_h, dh)
        cur = tp[:, :, blk:].reshape(b, dilation, nb, blk, n_h, dh)
        return jnp.concatenate([prev, cur], axis=3)

    kb, vb = key_blocks(ks), key_blocks(vs)
    sc = jnp.einsum('brnqhd,brnkhd->brnhqk', qb, kb).astype(jnp.float32) * dh ** -0.5
    n_idx = jnp.arange(nb)[:, None, None]
    i_idx = jnp.arange(blk)[None, :, None]
    j_idx = jnp.arange(2 * blk)[None, None, :]
    delta = i_idx + blk - j_idx
    valid = (delta >= 0) & (delta <= w_sub) & (n_idx * blk - blk + j_idx >= 0)
    bias = -slopes[None, :, None, None] * (delta * dilation).astype(jnp.float32)[:, None]
    sc = jnp.where(valid[:, None], sc + bias, -jnp.inf)
    m = jnp.max(sc, axis=-1, keepdims=True)
    p = jnp.exp(sc - m)
    denom = jnp.sum(p, axis=-1)
    o = jnp.einsum('brnhqk,brnkhd->brnqhd', p.astype(v.dtype), vb).astype(jnp.float32)
    o = o / jnp.moveaxis(denom, 3, 4)[..., None]
    lse = jnp.moveaxis(m[..., 0] + jnp.log(denom), 3, 4)

    def back(t):
        t = t.reshape((b, dilation, Lp) + t.shape[4:])[:, :, :L]
        t = jnp.swapaxes(t, 1, 2)
        return t.reshape((b, s_len) + t.shape[3:])

    return back(o).astype(q.dtype), back(lse)


def memory_branch(q_mem, mem, norm_mem, w_mem_kv):
    k_m, v_m = jnp.split(rmsnorm(mem, norm_mem) @ w_mem_kv, 2, axis=-1)
    q, k, v = _heads(q_mem, N_MEM_HEADS), _heads(k_m, N_MEM_HEADS), _heads(v_m, N_MEM_HEADS)
    sc = jnp.einsum('bqhd,bkhd->bhqk', q, k).astype(jnp.float32) * HEAD_DIM ** -0.5
    p = jax.nn.softmax(sc, axis=-1)
    o = jnp.einsum('bhqk,bkhd->bqhd', p.astype(v.dtype), v)
    return o.reshape(q_mem.shape)


def conv_ffn(x, w_up, w_conv, w_down):
    s_len = x.shape[1]
    u = x @ w_up
    up = jnp.pad(u, ((0, 0), (CONV_WIDTH - 1, 0), (0, 0)))
    c = w_conv[0] * up[:, 0:s_len]
    for j in range(1, CONV_WIDTH):
        c = c + w_conv[j] * up[:, j:j + s_len]
    a, g = jnp.split(c, 2, axis=-1)
    return (jax.nn.silu(g) * a) @ w_down


def self_decoder_layer(x, mem, norm_attn, w_in, w_out, norm_mem, w_mem_kv, norm_ffn, ffn_up, ffn_conv, ffn_down):
    b, s_len, _ = x.shape
    proj = rmsnorm(x, norm_attn) @ w_in
    q_sb, k_sb, v_sb, q_mem = jnp.split(proj, [SB_WIDTH, 2 * SB_WIDTH, 3 * SB_WIDTH], axis=-1)
    o_sb = stick_breaking_attention(_heads(q_sb, N_SB_HEADS), _heads(k_sb, N_SB_HEADS), _heads(v_sb, N_SB_HEADS))
    o_mem = memory_branch(q_mem, mem, norm_mem, w_mem_kv)
    x = x + jnp.concatenate([o_sb.reshape(b, s_len, SB_WIDTH), o_mem], axis=-1) @ w_out
    return x + conv_ffn(rmsnorm(x, norm_ffn), ffn_up, ffn_conv, ffn_down)


def cross_decoder_layer(x, k_sh, v_sh, mem, norm_attn, w_in, w_out, norm_mem, w_mem_kv, norm_ffn, ffn_up, ffn_conv, ffn_down):
    b, s_len, _ = x.shape
    proj = rmsnorm(x, norm_attn) @ w_in
    q_dil, q_mem = jnp.split(proj, [DIL_WIDTH], axis=-1)
    q_dil = _heads(q_dil, N_DIL_HEADS)
    slopes = alibi_slopes(N_DIL_HEADS)
    outs, lses = [], []
    for g, (window, dilation) in enumerate(DIL_GROUPS):
        hs = slice(g * HEADS_PER_GROUP, (g + 1) * HEADS_PER_GROUP)
        o_g, lse_g = dilated_window_attention(q_dil[:, :, hs], k_sh[:, :, hs], v_sh[:, :, hs], slopes[hs], window, dilation)
        outs.append(o_g)
        lses.append(lse_g)
    alpha = jax.nn.softmax(jnp.stack(lses, axis=0), axis=0)
    o_dil = jnp.concatenate([o * alpha[g][..., None].astype(o.dtype) for g, o in enumerate(outs)], axis=2)
    o_mem = memory_branch(q_mem, mem, norm_mem, w_mem_kv)
    x = x + jnp.concatenate([o_dil.reshape(b, s_len, DIL_WIDTH), o_mem], axis=-1) @ w_out
    return x + conv_ffn(rmsnorm(x, norm_ffn), ffn_up, ffn_conv, ffn_down)


def setup_inputs(seed: int = 0) -> dict:
    key = jax.random.key(seed)
    ks = jax.random.split(key, 24)

    def w(k, shape, fan_in):
        return jax.random.normal(k, shape, jnp.float32) * fan_in ** -0.5

    def gain(k, shape):
        return 1.0 + 0.02 * jax.random.normal(k, shape, jnp.float32)

    na, nb = N_A_LAYERS, N_B_LAYERS
    return {
        'x': jax.random.normal(ks[0], (BATCH, SEQ, D_MODEL), jnp.float32),
        'mem': jax.random.normal(ks[1], (BATCH, MEM_LEN, D_MODEL), jnp.float32),
        'a_norm_attn': gain(ks[2], (na, D_MODEL)),
        'a_w_in': w(ks[3], (na, D_MODEL, 3 * SB_WIDTH + MEM_WIDTH), D_MODEL),
        'a_w_out': w(ks[4], (na, SB_WIDTH + MEM_WIDTH, D_MODEL), SB_WIDTH + MEM_WIDTH),
        'a_norm_mem': gain(ks[5], (na, D_MODEL)),
        'a_w_mem_kv': w(ks[6], (na, D_MODEL, 2 * MEM_WIDTH), D_MODEL),
        'a_norm_ffn': gain(ks[7], (na, D_MODEL)),
        'a_ffn_up': w(ks[8], (na, D_MODEL, 2 * D_FF), D_MODEL),
        'a_ffn_conv': w(ks[9], (na, CONV_WIDTH, 2 * D_FF), CONV_WIDTH),
        'a_ffn_down': w(ks[10], (na, D_FF, D_MODEL), D_FF),
        'kv_norm': gain(ks[11], (D_MODEL,)),
        'w_kv_shared': w(ks[12], (D_MODEL, 2 * DIL_WIDTH), D_MODEL),
        'b_norm_attn': gain(ks[13], (nb, D_MODEL)),
        'b_w_in': w(ks[14], (nb, D_MODEL, DIL_WIDTH + MEM_WIDTH), D_MODEL),
        'b_w_out': w(ks[15], (nb, DIL_WIDTH + MEM_WIDTH, D_MODEL), DIL_WIDTH + MEM_WIDTH),
        'b_norm_mem': gain(ks[16], (nb, D_MODEL)),
        'b_w_mem_kv': w(ks[17], (nb, D_MODEL, 2 * MEM_WIDTH), D_MODEL),
        'b_norm_ffn': gain(ks[18], (nb, D_MODEL)),
        'b_ffn_up': w(ks[19], (nb, D_MODEL, 2 * D_FF), D_MODEL),
        'b_ffn_conv': w(ks[20], (nb, CONV_WIDTH, 2 * D_FF), CONV_WIDTH),
        'b_ffn_down': w(ks[21], (nb, D_FF, D_MODEL), D_FF),
        'final_norm': gain(ks[22], (D_MODEL,)),
    }


def reference(x, mem, a_norm_attn, a_w_in, a_w_out, a_norm_mem, a_w_mem_kv, a_norm_ffn, a_ffn_up, a_ffn_conv, a_ffn_down,
              kv_norm, w_kv_shared, b_norm_attn, b_w_in, b_w_out, b_norm_mem, b_w_mem_kv, b_norm_ffn, b_ffn_up, b_ffn_conv,
              b_ffn_down, final_norm):
    b, s_len, _ = x.shape
    h = x
    k_sh = None
    v_sh = None
    for layer in range(DEPTH):
        if layer < N_A_LAYERS:
            i = layer
            h = self_decoder_layer(h, mem, a_norm_attn[i], a_w_in[i], a_w_out[i], a_norm_mem[i], a_w_mem_kv[i],
                                   a_norm_ffn[i], a_ffn_up[i], a_ffn_conv[i], a_ffn_down[i])
            if layer == N_A_LAYERS - 1:
                k_flat, v_flat = jnp.split(rmsnorm(h, kv_norm) @ w_kv_shared, 2, axis=-1)
                k_sh = _heads(k_flat, N_DIL_HEADS)
                v_sh = _heads(v_flat, N_DIL_HEADS)
        else:
            j = layer - N_A_LAYERS
            h = cross_decoder_layer(h, k_sh, v_sh, mem, b_norm_attn[j], b_w_in[j], b_w_out[j], b_norm_mem[j],
                                    b_w_mem_kv[j], b_norm_ffn[j], b_ffn_up[j], b_ffn_conv[j], b_ffn_down[j])
    return rmsnorm(h, final_norm)
```

```cpp
#include <hip/hip_runtime.h>
#include <hip/hip_cooperative_groups.h>
#include <cstdio>
#include <cstdint>
namespace cg = cooperative_groups;
namespace pg8 {
#define PG8_LAS __attribute__((address_space(3)))
typedef unsigned short bf16_t;
typedef short bf16x8 __attribute__((ext_vector_type(8)));
typedef float f32x4 __attribute__((ext_vector_type(4)));
typedef unsigned u32x4 __attribute__((ext_vector_type(4)));
constexpr int BM = 256, BK = 64, HALF = 128, HTB = HALF * BK * 2  , STAGE_BYTES = 8 * HTB, NXCD = 8, WGM = 8;

__host__ __device__ __forceinline__ int lds_byte(int r, int c) { const int st = (r >> 4) * 2 + (c >> 5), rr = r & 15, cc = c & 31, ob = rr * 64 + cc * 2; return st * 1024 + (ob ^ (((ob >> 9) & 1) << 5)); }
__host__ __device__ __forceinline__ void stage_rc(int b, int& R, int& C) { const int st = b / 1024, sb = b % 1024, swz = sb ^ (((sb >> 9) & 1) << 5); R = (st >> 1) * 16 + swz / 64; C = (st & 1) * 32 + (swz % 64) / 2; }
__host__ __device__ __forceinline__ int perm32(int rho) { const int n = rho >> 4, i = rho & 15; return 8 * (i >> 2) + 4 * n + (i & 3); }

struct Unit { int pm, pn; };
struct Gemm { const bf16_t* A; const bf16_t* Bt; int M, N, K; };

struct StaticOrder {
    int nM, nN, nwg, G, c;
    __host__ __device__ void init(int M, int N, int G_, int c_) { nM = M / BM; nN = N / BM; nwg = nM * nN; G = G_; c = c_; }
    __host__ __device__ bool next(int i, Unit& u) const {
        const long L = (long)i * G + c; if (L >= nwg) return false;
        int wgid = (int)L; { const int q = nwg / NXCD, r = nwg % NXCD, xcd = wgid % NXCD, off = wgid / NXCD; wgid = (xcd < r ? xcd * (q + 1) : r * (q + 1) + (xcd - r) * q) + off; }
        const int nig = WGM * nN, gid = wgid / nig, fm = gid * WGM, gsz = (nM - fm) < WGM ? (nM - fm) : WGM;
        u.pm = fm + ((wgid % nig) % gsz); u.pn = (wgid % nig) / gsz; return true;
    }
    __device__ __forceinline__ void a_ready(const Unit&) const {}
    __device__ __forceinline__ void done(const Unit&) const {}
};
__device__ __forceinline__ unsigned cvt_pk_bf16(float lo, float hi) { unsigned r; asm volatile("v_cvt_pk_bf16_f32 %0, %1, %2" : "=v"(r) : "v"(lo), "v"(hi)); return r; }
typedef float f32x2 __attribute__((ext_vector_type(2)));
typedef unsigned u32x2 __attribute__((ext_vector_type(2)));
constexpr float RMS_EPS = 1e-6f;
__device__ __forceinline__ float row_rstd(const float* ssp, int row) {
    const f32x4* p = (const f32x4*)(ssp + (size_t)row * 16);
    const f32x4 a = p[0], b = p[1], c = p[2], d = p[3];
    const float s = (((a[0] + a[1]) + (a[2] + a[3])) + ((b[0] + b[1]) + (b[2] + b[3]))) + (((c[0] + c[1]) + (c[2] + c[3])) + ((d[0] + d[1]) + (d[2] + d[3])));
    return __builtin_amdgcn_rsqf(s * (1.0f / 1024.0f) + RMS_EPS);
}
__device__ __forceinline__ void rows_rstd8(float (&rs)[2][4], const float* ssp, int row0, int fq) {
    f32x4 part[2][4];
#pragma unroll
    for (int ai = 0; ai < 2; ++ai)
#pragma unroll
        for (int m = 0; m < 4; ++m) part[ai][m] = *(const f32x4*)(ssp + (size_t)(row0 + ai * HALF + m * 16) * 16 + 4 * fq);
#pragma unroll
    for (int ai = 0; ai < 2; ++ai)
#pragma unroll
        for (int m = 0; m < 4; ++m) { float s = (part[ai][m][0] + part[ai][m][1]) + (part[ai][m][2] + part[ai][m][3]); s += __shfl_xor(s, 16); s += __shfl_xor(s, 32);
            rs[ai][m] = __builtin_amdgcn_rsqf(s * (1.0f / 1024.0f) + RMS_EPS); }
}
struct EpiScaleBf16 {
    static constexpr bool PERM = true, AFTER_DRAIN = false;
    bf16_t* O; int ldc; const float* ssp;
    __device__ __forceinline__ void operator()(const f32x4 (&acc)[2][2][4][2], const Unit& u, int wr, int wc, int fr, int fq) const {
        const int row0 = u.pm * BM + wr * 64 + fr, col0 = u.pn * BM + wc * 32 + 8 * fq;
        float rsv[2][4]; rows_rstd8(rsv, ssp, row0, fq);
#pragma unroll
        for (int ai = 0; ai < 2; ++ai)
#pragma unroll
            for (int m = 0; m < 4; ++m) { const int row = row0 + ai * HALF + m * 16; const float rs = rsv[ai][m]; bf16_t* rowp = O + (size_t)row * ldc + col0;
#pragma unroll
                for (int bj = 0; bj < 2; ++bj) { const f32x4 v0 = acc[ai][bj][m][0] * rs, v1 = acc[ai][bj][m][1] * rs;
                    u32x4 w; w.x = cvt_pk_bf16(v0[0], v0[1]); w.y = cvt_pk_bf16(v0[2], v0[3]); w.z = cvt_pk_bf16(v1[0], v1[1]); w.w = cvt_pk_bf16(v1[2], v1[3]);
                    *(u32x4*)(rowp + bj * HALF) = w; } }
    }
};
struct EpiResid {
    static constexpr bool PERM = true, AFTER_DRAIN = false;
    const bf16_t* base; bf16_t* hb; float* outf; float* ssp;
    __device__ __forceinline__ void operator()(const f32x4 (&acc)[2][2][4][2], const Unit& u, int wr, int wc, int fr, int fq) const {
        const int row0 = u.pm * BM + wr * 64 + fr, col0 = u.pn * BM + wc * 32 + 8 * fq;
#pragma unroll
        for (int ai = 0; ai < 2; ++ai) {
            u32x4 bs[4][2];
#pragma unroll
            for (int m = 0; m < 4; ++m)
#pragma unroll
                for (int bj = 0; bj < 2; ++bj) bs[m][bj] = *(const u32x4*)(base + (size_t)(row0 + ai * HALF + m * 16) * 1024 + col0 + bj * HALF);
#pragma unroll
            for (int m = 0; m < 4; ++m) { const int row = row0 + ai * HALF + m * 16; const size_t off = (size_t)row * 1024 + col0; float ss = 0.f;
#pragma unroll
                for (int bj = 0; bj < 2; ++bj) { const size_t o2 = off + bj * HALF; const u32x4 b = bs[m][bj];
                    f32x4 v0, v1;
                    v0[0] = __uint_as_float(b.x << 16); v0[1] = __uint_as_float(b.x & 0xffff0000u); v0[2] = __uint_as_float(b.y << 16); v0[3] = __uint_as_float(b.y & 0xffff0000u);
                    v1[0] = __uint_as_float(b.z << 16); v1[1] = __uint_as_float(b.z & 0xffff0000u); v1[2] = __uint_as_float(b.w << 16); v1[3] = __uint_as_float(b.w & 0xffff0000u);
                    v0 += acc[ai][bj][m][0]; v1 += acc[ai][bj][m][1];
                    ss += ((v0[0] * v0[0] + v0[1] * v0[1]) + (v0[2] * v0[2] + v0[3] * v0[3])) + ((v1[0] * v1[0] + v1[1] * v1[1]) + (v1[2] * v1[2] + v1[3] * v1[3]));
                    if (hb) { u32x4 w; w.x = cvt_pk_bf16(v0[0], v0[1]); w.y = cvt_pk_bf16(v0[2], v0[3]); w.z = cvt_pk_bf16(v1[0], v1[1]); w.w = cvt_pk_bf16(v1[2], v1[3]); *(u32x4*)(hb + o2) = w; }
                    if (outf) { *(f32x4*)(outf + o2) = v0; *(f32x4*)(outf + o2 + 4) = v1; } }
                ss += __shfl_xor(ss, 16); ss += __shfl_xor(ss, 32);
                if (fq == 0) ssp[(size_t)row * 16 + u.pn * 4 + wc] = ss; }
        }
    }
};
struct EpiConvGate {
    static constexpr bool PERM = true, AFTER_DRAIN = false;
    bf16_t* act; const float* ssp; const float* cw; float* side; PG8_LAS f32x4* X;
    __device__ __forceinline__ void operator()(const f32x4 (&acc)[2][2][4][2], const Unit& u, int wr, int wc, int fr, int fq) const {
        const int lane = threadIdx.x & 63, wid = wr * 4 + wc;
        const int rowb = u.pm * BM + wr * 64 + fr;
        float rs[2][4]; rows_rstd8(rs, ssp, rowb, fq);
        const int cn0 = u.pn * BM + wc * 32 + 8 * fq;
        if (fr >= 14) {
#pragma unroll
            for (int ai = 0; ai < 2; ++ai)
#pragma unroll
                for (int bj = 0; bj < 2; ++bj)
#pragma unroll
                    for (int n = 0; n < 2; ++n) { const f32x4 v = acc[ai][bj][3][n] * rs[ai][3];
                        X[((((wid * 2 + ai) * 2 + (fr - 14)) * 2 + bj) * 2 + n) * 4 + fq] = v;
                        if (ai == 1 && wr == 1) *(f32x4*)(side + ((size_t)u.pm * 4 + 2 + (fr - 14)) * 5632 + cn0 + bj * HALF + 4 * n) = v; }
        }
        if (wr == 0 && fr < 2) {
#pragma unroll
            for (int bj = 0; bj < 2; ++bj)
#pragma unroll
                for (int n = 0; n < 2; ++n) *(f32x4*)(side + ((size_t)u.pm * 4 + fr) * 5632 + cn0 + bj * HALF + 4 * n) = acc[0][bj][0][n] * rs[0][0];
        }
        asm volatile("s_waitcnt lgkmcnt(0)" ::: "memory"); __builtin_amdgcn_s_barrier(); asm volatile("" ::: "memory");
        const int fcol = u.pn * 128 + wc * 32 + 8 * fq;
#pragma unroll
        for (int n = 0; n < 2; ++n) {
            f32x4 w[3][2];
#pragma unroll
            for (int k = 0; k < 3; ++k)
#pragma unroll
                for (int bj = 0; bj < 2; ++bj) w[k][bj] = *(const f32x4*)(cw + k * 5632 + cn0 + bj * HALF + 4 * n);
#pragma unroll
            for (int ai = 0; ai < 2; ++ai) {
                const int q = 2 * ai + wr;
                f32x4 s1p[2], s2p[2];
                if (q == 0) { s1p[0] = s1p[1] = s2p[0] = s2p[1] = (f32x4){0.f, 0.f, 0.f, 0.f}; }
                else { const int pq = q - 1, pwid = (pq & 1) * 4 + wc, pai = pq >> 1;
#pragma unroll
                    for (int bj = 0; bj < 2; ++bj) { s1p[bj] = X[((((pwid * 2 + pai) * 2 + 1) * 2 + bj) * 2 + n) * 4 + fq]; s2p[bj] = X[((((pwid * 2 + pai) * 2 + (fr & 1)) * 2 + bj) * 2 + n) * 4 + fq]; } }
#pragma unroll
                for (int m = 0; m < 4; ++m) {
                    f32x4 c[2];
#pragma unroll
                    for (int bj = 0; bj < 2; ++bj) { const f32x4 cur = acc[ai][bj][m][n] * rs[ai][m]; f32x4 s1, s2;
#pragma unroll
                        for (int e = 0; e < 4; ++e) {
                            float a1, a2; const float ce = cur[e];
                            asm("s_nop 1\n\tv_mov_b32_dpp %0, %1 row_ror:1 row_mask:0xf bank_mask:0xf" : "=v"(a1) : "v"(ce));
                            asm("v_mov_b32_dpp %0, %1 row_ror:2 row_mask:0xf bank_mask:0xf" : "=v"(a2) : "v"(ce), "v"(a1));
                            s1[e] = a1; s2[e] = a2; }
                        const f32x4 p1 = (fr == 0) ? s1p[bj] : s1, p2 = (fr < 2) ? s2p[bj] : s2;
                        c[bj] = w[2][bj] * cur + w[1][bj] * p1 + w[0][bj] * p2; s1p[bj] = s1; s2p[bj] = s2; }
                    f32x4 o;
#pragma unroll
                    for (int e = 0; e < 4; ++e) { const float g = c[1][e]; const float sg = g * __builtin_amdgcn_rcpf(1.f + __builtin_amdgcn_exp2f(-1.4426950408889634f * g)); o[e] = c[0][e] * sg; }
                    u32x2 pk; pk.x = cvt_pk_bf16(o[0], o[1]); pk.y = cvt_pk_bf16(o[2], o[3]);
                    *(u32x2*)(act + (size_t)(rowb + ai * HALF + m * 16) * 2816 + fcol + 4 * n) = pk;
                    asm volatile("" ::: "memory");
                }
            }
        }
    }
};
template <class Epi, class Sched, bool ALIGN_EPI = false, bool SP2 = false>
__device__ __forceinline__ void gemm_phase(PG8_LAS unsigned char* lds, const Gemm g, const Sched& S, const Epi& E) {
    const int tid = threadIdx.x, wid = __builtin_amdgcn_readfirstlane(tid >> 6), lane = tid & 63, wr = wid >> 2, wc = wid & 3, fr = lane & 15, fq = lane >> 4;
    const int K = g.K, nt = K / BK;
    unsigned voffA[2], voffB[2];
#pragma unroll
    for (int i = 0; i < 2; ++i) { int R, C; stage_rc(tid * 16 + i * 8192, R, C); const int Rb = Epi::PERM ? ((R & ~31) + perm32(R & 31)) : R;
        voffA[i] = (unsigned)(R * K + C) * 2u; voffB[i] = (unsigned)(Rb * K + C) * 2u; }
    const size_t kstep = (size_t)(BK * 2);
    const size_t hstep = (size_t)HALF * K * 2;
    const size_t tstep = 2 * hstep;
    const unsigned ldsw = (unsigned)wid * 1024u;
    const int aoff = lds_byte(wr * 64 + fr, fq * 8), boff = lds_byte(wc * 32 + fr, fq * 8);
#define PG8_SA(b, h) (((b) * 2 + (h)) * HTB)
#define PG8_SB(b, h) ((4 + (b) * 2 + (h)) * HTB)
#define PG8_STAGE(bufoff, gbase, voff) do { _Pragma("unroll") for (int _i = 0; _i < 2; ++_i) \
        __builtin_amdgcn_global_load_lds((const unsigned*)((const char*)(gbase) + (voff)[_i]), (PG8_LAS unsigned*)(lds + (bufoff) + ldsw + _i * 8192), 16, 0, 0); } while (0)
#define PG8_LDA(dst, b, h) do { _Pragma("unroll") for (int m = 0; m < 4; ++m) _Pragma("unroll") for (int k = 0; k < 2; ++k) dst[m][k] = *(const PG8_LAS bf16x8*)(lds + PG8_SA(b, h) + aoff + m * 2048 + k * 1024); } while (0)
#define PG8_LDB(dst, b, h) do { _Pragma("unroll") for (int n = 0; n < 2; ++n) _Pragma("unroll") for (int k = 0; k < 2; ++k) dst[n][k] = *(const PG8_LAS bf16x8*)(lds + PG8_SB(b, h) + boff + n * 2048 + k * 1024); } while (0)
#define PG8_MMA(ai, bj, At, Bt) do { __builtin_amdgcn_s_setprio(1); _Pragma("unroll") for (int m = 0; m < 4; ++m) _Pragma("unroll") for (int n = 0; n < 2; ++n) _Pragma("unroll") for (int k = 0; k < 2; ++k) \
        acc[ai][bj][m][n] = __builtin_amdgcn_mfma_f32_16x16x32_bf16(Bt[n][k], At[m][k], acc[ai][bj][m][n], 0, 0, 0); __builtin_amdgcn_s_setprio(0); } while (0)
#define PG8_WAIT_V(n) asm volatile("s_waitcnt vmcnt(" #n ")" ::: "memory")
#define PG8_WAIT_L(n) asm volatile("s_waitcnt lgkmcnt(" #n ")" ::: "memory")
#define PG8_BAR __builtin_amdgcn_s_barrier()
#define PG8_SCHED __builtin_amdgcn_sched_barrier(0)
    Unit cur, nxt; int ui = 0;
    if (!S.next(0, cur)) return;
    f32x4 acc[2][2][4][2];
#pragma unroll
    for (int a = 0; a < 2; ++a)
#pragma unroll
        for (int b = 0; b < 2; ++b)
#pragma unroll
            for (int m = 0; m < 4; ++m)
#pragma unroll
                for (int n = 0; n < 2; ++n) acc[a][b][m][n] = (f32x4){0.f, 0.f, 0.f, 0.f};
    bf16x8 At[4][2], B0[2][2], B1[2][2];
    const char* cA = (const char*)g.A + (size_t)cur.pm * tstep; const char* cB = (const char*)g.Bt + (size_t)cur.pn * tstep;
    S.a_ready(cur);
    if constexpr (SP2) {
        PG8_STAGE(PG8_SB(0, 0), cB, voffB); PG8_STAGE(PG8_SB(0, 1), cB + hstep, voffB); PG8_STAGE(PG8_SA(0, 0), cA, voffA); PG8_STAGE(PG8_SA(0, 1), cA + hstep, voffA);
        if (wr == 1) PG8_BAR;
        PG8_WAIT_V(2); PG8_BAR;
        PG8_STAGE(PG8_SB(1, 0), cB + kstep, voffB); PG8_STAGE(PG8_SA(1, 0), cA + kstep, voffA); PG8_STAGE(PG8_SB(1, 1), cB + hstep + kstep, voffB);
        PG8_WAIT_V(6); PG8_BAR;
    } else {
        PG8_STAGE(PG8_SB(0, 0), cB, voffB); PG8_STAGE(PG8_SA(0, 0), cA, voffA); PG8_STAGE(PG8_SB(0, 1), cB + hstep, voffB); PG8_STAGE(PG8_SA(0, 1), cA + hstep, voffA);
        if (wr == 1) PG8_BAR;
        PG8_WAIT_V(4); PG8_BAR;
        PG8_STAGE(PG8_SB(1, 0), cB + kstep, voffB); PG8_STAGE(PG8_SA(1, 0), cA + kstep, voffA); PG8_STAGE(PG8_SB(1, 1), cB + hstep + kstep, voffB);
        PG8_WAIT_V(6); PG8_BAR;
    }
    for (;;) {
        const bool has_next = S.next(ui + 1, nxt);
        const char* nA = has_next ? (const char*)g.A + (size_t)nxt.pm * tstep : cA; const char* nB = has_next ? (const char*)g.Bt + (size_t)nxt.pn * tstep : cB;
        for (int t = 0; t < nt; t += 2) {
            const bool last = (t == nt - 2);
            const char* a1 = cA + (size_t)(t + 1) * kstep;
            const char* a2 = last ? nA : cA + (size_t)(t + 2) * kstep; const char* b2 = last ? nB : cB + (size_t)(t + 2) * kstep;
            const char* a3 = a2 + kstep; const char* b3 = b2 + kstep;
            if (last && has_next) S.a_ready(nxt);
            if constexpr (SP2) {
            PG8_LDB(B0, 0, 0); PG8_LDB(B1, 0, 1); PG8_SCHED; PG8_LDA(At, 0, 0); PG8_STAGE(PG8_SA(1, 1), a1 + hstep, voffA);
            PG8_WAIT_V(8); PG8_WAIT_L(0); PG8_BAR; PG8_MMA(0, 0, At, B0); PG8_MMA(0, 1, At, B1); PG8_BAR; PG8_SCHED;
            PG8_LDA(At, 0, 1); PG8_STAGE(PG8_SB(0, 0), b2, voffB); PG8_STAGE(PG8_SB(0, 1), b2 + hstep, voffB); PG8_STAGE(PG8_SA(0, 0), a2, voffA);
            PG8_WAIT_V(8); PG8_WAIT_L(0); PG8_BAR; PG8_MMA(1, 0, At, B0); PG8_MMA(1, 1, At, B1); PG8_BAR; PG8_SCHED;
            PG8_LDB(B0, 1, 0); PG8_LDB(B1, 1, 1); PG8_SCHED; PG8_LDA(At, 1, 0); PG8_STAGE(PG8_SA(0, 1), a2 + hstep, voffA);
            PG8_WAIT_V(8); PG8_WAIT_L(0); PG8_BAR; PG8_MMA(0, 0, At, B0); PG8_MMA(0, 1, At, B1); PG8_BAR; PG8_SCHED;
            PG8_LDA(At, 1, 1); PG8_STAGE(PG8_SB(1, 0), b3, voffB); PG8_STAGE(PG8_SB(1, 1), b3 + hstep, voffB); PG8_STAGE(PG8_SA(1, 0), a3, voffA);
            PG8_WAIT_V(8); PG8_WAIT_L(0); PG8_BAR; PG8_MMA(1, 0, At, B0); PG8_MMA(1, 1, At, B1); PG8_BAR; PG8_SCHED;
            } else {
            PG8_LDB(B0, 0, 0); PG8_SCHED; PG8_LDA(At, 0, 0); PG8_STAGE(PG8_SA(1, 1), a1 + hstep, voffA);
            PG8_WAIT_L(8); PG8_BAR; PG8_WAIT_L(0); PG8_MMA(0, 0, At, B0); PG8_BAR; PG8_SCHED;
            PG8_LDB(B1, 0, 1); PG8_STAGE(PG8_SB(0, 0), b2, voffB);
            PG8_BAR; PG8_WAIT_L(0); PG8_MMA(0, 1, At, B1); PG8_BAR;
            PG8_LDA(At, 0, 1); PG8_STAGE(PG8_SA(0, 0), a2, voffA);
            PG8_BAR; PG8_WAIT_L(0); PG8_MMA(1, 0, At, B0); PG8_BAR; PG8_SCHED;
            PG8_STAGE(PG8_SB(0, 1), b2 + hstep, voffB);
            PG8_WAIT_V(6); PG8_BAR; PG8_MMA(1, 1, At, B1); PG8_BAR;
            PG8_LDB(B0, 1, 0); PG8_SCHED; PG8_LDA(At, 1, 0); PG8_STAGE(PG8_SA(0, 1), a2 + hstep, voffA);
            PG8_WAIT_L(8); PG8_BAR; PG8_WAIT_L(0); PG8_MMA(0, 0, At, B0); PG8_BAR; PG8_SCHED;
            PG8_LDB(B1, 1, 1); PG8_STAGE(PG8_SB(1, 0), b3, voffB);
            PG8_BAR; PG8_WAIT_L(0); PG8_MMA(0, 1, At, B1); PG8_BAR;
            PG8_LDA(At, 1, 1); PG8_STAGE(PG8_SA(1, 0), a3, voffA);
            PG8_BAR; PG8_WAIT_L(0); PG8_MMA(1, 0, At, B0); PG8_BAR; PG8_SCHED;
            PG8_STAGE(PG8_SB(1, 1), b3 + hstep, voffB);
            PG8_WAIT_V(6); PG8_BAR; PG8_MMA(1, 1, At, B1); PG8_BAR;
            }
        }
        if constexpr (ALIGN_EPI) { if (wr == 0) PG8_BAR; }
        if constexpr (!Epi::AFTER_DRAIN) { E(acc, cur, wr, wc, fr, fq); S.done(cur); }
        if (!has_next) break;
#pragma unroll
        for (int a = 0; a < 2; ++a)
#pragma unroll
            for (int b = 0; b < 2; ++b)
#pragma unroll
                for (int m = 0; m < 4; ++m)
#pragma unroll
                    for (int n = 0; n < 2; ++n) acc[a][b][m][n] = (f32x4){0.f, 0.f, 0.f, 0.f};
        cur = nxt; cA = nA; cB = nB; ++ui;
        if constexpr (ALIGN_EPI) { if (wr == 1) PG8_BAR; }
    }
    PG8_WAIT_V(0);
    if constexpr (!ALIGN_EPI) { if (wr == 0) PG8_BAR; }
    PG8_BAR;
    if constexpr (Epi::AFTER_DRAIN) { E.fused(acc, cur, wr, wc, fr, fq, lds, wid, lane); S.done(cur); }
#undef PG8_SA
#undef PG8_SB
#undef PG8_STAGE
#undef PG8_LDA
#undef PG8_LDB
#undef PG8_MMA
#undef PG8_WAIT_V
#undef PG8_WAIT_L
#undef PG8_BAR
#undef PG8_SCHED
}
}
#define LAS __attribute__((address_space(3)))
typedef unsigned short bf16;
typedef short bf16x8 __attribute__((ext_vector_type(8)));
typedef float f32x4 __attribute__((ext_vector_type(4)));
typedef float f32x16 __attribute__((ext_vector_type(16)));
typedef unsigned u32x4 __attribute__((ext_vector_type(4)));
typedef unsigned u32x2 __attribute__((ext_vector_type(2)));
constexpr int NB = 32, SEQ = 2048, D = 1024, MTOK = NB * SEQ, MEML = 256, MMEM = NB * MEML, DFF = 2816, NUP = 2 * DFF, NPROJ = 2560;
constexpr float LOG2E = 1.4426950408889634f, QS = 0.125f * LOG2E;
constexpr size_t MiB = 1u << 20;
constexpr size_t WS_W1 = 0 * MiB, WS_W3 = 5 * MiB, WS_WM = 7 * MiB, WS_W4 = 9 * MiB, WS_W5 = 20 * MiB, WS_W6 = 26 * MiB, WS_W8 = 31 * MiB, WS_W9 = 33 * MiB, WS_W10 = 44 * MiB;
constexpr size_t WS_CWP = 50 * MiB, WS_SSPX = 51 * MiB, WS_SSP1 = 55 * MiB, WS_SSP2 = 59 * MiB, WS_SSP3 = 63 * MiB, WS_SSP4 = 67 * MiB, WS_SSPM = 71 * MiB;
constexpr size_t WS_LSE = 72 * MiB, WS_SIDE = 76 * MiB, WS_MEMB = 98 * MiB, WS_MEMKV = 114 * MiB, WS_HB = 130 * MiB, WS_PROJ = 258 * MiB, WS_ATT = 578 * MiB, WS_ACT = 258 * MiB, WS_CTL = 706 * MiB, CTL_BYTES = 16384, WS_END = 707 * MiB;
constexpr int NWAVES = 8, NTHREADS = 512;
constexpr int LDS_X_OFF = 131072, LDS_MISC_OFF = 131072 + 8192, LDS_BYTES = 147456;

__device__ __forceinline__ unsigned cvtpk(float lo, float hi) { unsigned r; asm volatile("v_cvt_pk_bf16_f32 %0, %1, %2" : "=v"(r) : "v"(lo), "v"(hi)); return r; }
__device__ __forceinline__ float wave_sum(float v) {
#pragma unroll
    for (int o = 1; o < 64; o <<= 1) v += __shfl_xor(v, o);
    return v;
}
__device__ __forceinline__ float ex2(float x) { return __builtin_amdgcn_exp2f(x); }
__device__ __forceinline__ float lg2(float x) { return __builtin_amdgcn_logf(x); }

namespace att {
constexpr int KT_BYTES = 64 * 144, VT_BYTES = 64 * 144, HEAD_BYTES = KT_BYTES + VT_BYTES, BUF_BYTES = 2 * HEAD_BYTES, FLAG_OFF = 2 * BUF_BYTES;
struct TileRegs { u32x4 k[2], v[2]; };
template <int NH> __device__ __forceinline__ void tile_load(TileRegs& t, const bf16* K, const bf16* V, int pitch, long tok0, int tstride, int tid) {
#pragma unroll
    for (int i = 0; i < NH; ++i) { const int cid = tid + NTHREADS * i, key = cid / (8 * NH), cc = cid % (8 * NH);
        const size_t off = (size_t)(tok0 + (long)key * tstride) * pitch + cc * 8;
        t.k[i] = *(const u32x4*)(K + off); t.v[i] = *(const u32x4*)(V + off); }
}
template <int NH> __device__ __forceinline__ void tile_store(const TileRegs& t, LAS unsigned char* lds, int tid) {
#pragma unroll
    for (int i = 0; i < NH; ++i) { const int cid = tid + NTHREADS * i, key = cid / (8 * NH), cc = cid % (8 * NH), h2 = cc / 8, c8 = cc % 8;
        *(LAS u32x4*)(lds + h2 * HEAD_BYTES + key * 144 + c8 * 16) = t.k[i];
        *(LAS u32x4*)(lds + h2 * HEAD_BYTES + KT_BYTES + key * 144 + c8 * 16) = t.v[i]; }
}
struct UDesc { const bf16* q; const bf16* K; const bf16* V; int pitch; long tok0; int tstride; int nh; };
__device__ __forceinline__ void unit_prefetch(TileRegs& t, bf16x8 (&qf)[4], const UDesc& d, int tid) {
    if (d.q) { const int hi = (tid >> 5) & 1;
        if (d.nh == 2) tile_load<2>(t, d.K, d.V, d.pitch, d.tok0, d.tstride, tid); else tile_load<1>(t, d.K, d.V, d.pitch, d.tok0, d.tstride, tid);
#pragma unroll
        for (int d0 = 0; d0 < 4; ++d0) qf[d0] = *(const bf16x8*)(d.q + d0 * 16 + hi * 8); }
}
template <bool BIAS = false> __device__ __forceinline__ void st_tile(f32x16 (&p)[2], const LAS unsigned char* kt, const bf16x8 (&qf)[4], int r32, int hi, float binit0 = 0.f, float bslope = 0.f) {
#pragma unroll
    for (int kh = 0; kh < 2; ++kh) { f32x16 a = {};
        if (BIAS) {
#pragma unroll
            for (int r = 0; r < 16; ++r) a[r] = __builtin_fmaf(bslope, (float)(32 * kh + 8 * (r >> 2) + (r & 3)), binit0); }
#pragma unroll
        for (int d0 = 0; d0 < 4; ++d0) { const bf16x8 kf = *(const LAS bf16x8*)(kt + (kh * 32 + r32) * 144 + d0 * 32 + hi * 16); a = __builtin_amdgcn_mfma_f32_32x32x16_bf16(kf, qf[d0], a, 0, 0, 0); }
        p[kh] = a; }
}
typedef short v4i16_t __attribute__((ext_vector_type(4)));
__device__ __forceinline__ v4i16_t vtr(const LAS unsigned char* p) { return __builtin_amdgcn_ds_read_tr16_b64_v4i16((LAS v4i16_t*)p); }
__device__ __forceinline__ void pv_tile(f32x16 (&o)[2], const LAS unsigned char* vt, const f32x16 (&p)[2], int lane) {
    const int l16 = lane & 15, g1 = (lane >> 4) & 1, hi = lane >> 5;
    const LAS unsigned char* vl = vt + (4 * hi + (l16 >> 2)) * 144 + (16 * g1 + 4 * (l16 & 3)) * 2;
#pragma unroll
    for (int kh = 0; kh < 2; ++kh)
#pragma unroll
        for (int a = 0; a < 2; ++a) { u32x4 pw; pw.x = cvtpk(p[kh][8 * a + 0], p[kh][8 * a + 1]); pw.y = cvtpk(p[kh][8 * a + 2], p[kh][8 * a + 3]); pw.z = cvtpk(p[kh][8 * a + 4], p[kh][8 * a + 5]); pw.w = cvtpk(p[kh][8 * a + 6], p[kh][8 * a + 7]);
            const bf16x8 pb = __builtin_bit_cast(bf16x8, pw);
#pragma unroll
            for (int dh = 0; dh < 2; ++dh) { const LAS unsigned char* vp = vl + (kh * 32 + 16 * a) * 144 + dh * 64;
                const v4i16_t lo = vtr(vp), hi4 = vtr(vp + 8 * 144);
                const bf16x8 va = (bf16x8){lo[0], lo[1], lo[2], lo[3], hi4[0], hi4[1], hi4[2], hi4[3]};
                o[dh] = __builtin_amdgcn_mfma_f32_32x32x16_bf16(va, pb, o[dh], 0, 0, 0); } }
}
__device__ __forceinline__ void store_o(bf16* op, const f32x16 (&o)[2], float sc, int hi) {
#pragma unroll
    for (int dh = 0; dh < 2; ++dh)
#pragma unroll
        for (int c = 0; c < 4; ++c) { u32x2 w; w.x = cvtpk(o[dh][4 * c] * sc, o[dh][4 * c + 1] * sc); w.y = cvtpk(o[dh][4 * c + 2] * sc, o[dh][4 * c + 3] * sc);
            *(u32x2*)(op + dh * 32 + 8 * c + 4 * hi) = w; }
}

constexpr float SB_DONE = 151.0f;
__device__ __forceinline__ void sb_unit(LAS unsigned char* lds, int& pb, TileRegs& tr, bf16x8 (&qf)[4], const UDesc& nxt, const bf16* PROJ, bf16* ATT, int b, int h, int qb, int tid) {
    const int lane = tid & 63, r32 = lane & 31, hi = lane >> 5, wid = __builtin_amdgcn_readfirstlane(tid >> 6);
    const long tokb = (long)b * SEQ; const int tq = qb * 256 + wid * 32 + r32;
    const bf16* Kb = PROJ + 768 + h * 64; const bf16* Vb = PROJ + 1536 + h * 64;
    f32x16 o[2]; o[0] = f32x16{}; o[1] = f32x16{};
    float carry = 0.f;
    const int kt_last = qb * 4 + 3, tq_min = qb * 256 + wid * 32, tq_max = tq_min + 31;
    TileRegs nx; bf16x8 qn[4];
    volatile LAS int* flags = (volatile LAS int*)(lds + FLAG_OFF);
    bool done = false; int par = 0;
    tile_store<1>(tr, lds + pb * BUF_BYTES, tid);
    tile_load<1>(tr, Kb, Vb, NPROJ, tokb + (kt_last - 1) * 64, 1, tid);
    unit_prefetch(nx, qn, nxt, tid);
    __syncthreads();
#pragma unroll 1
    for (int kt = kt_last; kt >= 0; --kt) {
        const LAS unsigned char* cur = lds + pb * BUF_BYTES;
        if (kt > 0) { tile_store<1>(tr, lds + (pb ^ 1) * BUF_BYTES, tid); if (kt > 1) tile_load<1>(tr, Kb, Vb, NPROJ, tokb + (kt - 2) * 64, 1, tid); }
        const int k0 = kt * 64;
        if (!done && k0 < tq_max) {
            f32x16 p[2]; st_tile(p, cur, qf, r32, hi);
            if (k0 + 63 >= tq_min) {
#pragma unroll
                for (int kh = 0; kh < 2; ++kh)
#pragma unroll
                    for (int r = 0; r < 16; ++r) { const int kpos = k0 + kh * 32 + 8 * (r >> 2) + 4 * hi + (r & 3); if (kpos >= tq) p[kh][r] = -1e30f; }
            }
            f32x16 l[2]; float gs[8];
#pragma unroll
            for (int kh = 0; kh < 2; ++kh) {
#pragma unroll
                for (int r = 0; r < 16; ++r) { float z; asm("v_min_f32 %0, %1, %2" : "=v"(z) : "v"(p[kh][r]), "v"(100.f)); p[kh][r] = z; l[kh][r] = lg2(1.f + ex2(z)); }
#pragma unroll
                for (int c = 0; c < 4; ++c) gs[kh * 4 + c] = (l[kh][4 * c] + l[kh][4 * c + 1]) + (l[kh][4 * c + 2] + l[kh][4 * c + 3]);
            }
            float pg[8], T[8], E[8];
#pragma unroll
            for (int j = 0; j < 8; ++j) { pg[j] = __shfl_xor(gs[j], 32); T[j] = gs[j] + pg[j]; }
            float st = 0.f;
#pragma unroll
            for (int j = 7; j >= 0; --j) { E[j] = carry + st + (hi == 0 ? pg[j] : 0.f); st += T[j]; }
            carry += st;
#pragma unroll
            for (int kh = 0; kh < 2; ++kh)
#pragma unroll
                for (int c = 0; c < 4; ++c) { float lat = E[kh * 4 + c];
#pragma unroll
                    for (int i = 3; i >= 0; --i) { const int r = 4 * c + i; lat += l[kh][r]; p[kh][r] = ex2(p[kh][r] - lat); } }
            pv_tile(o, cur + KT_BYTES, p, lane);
            done = __all(carry > SB_DONE);
        }
        if (lane == 0) flags[par * 8 + wid] = done ? 0 : 1;
        __syncthreads();
        pb ^= 1;
        int any = 0;
#pragma unroll
        for (int w = 0; w < 8; ++w) any |= flags[par * 8 + w];
        par ^= 1;
        if (!any) break;
    }
    store_o(ATT + (size_t)(tokb + tq) * D + h * 64, o, 1.f, hi);
    if (nxt.q) { tr = nx;
#pragma unroll
        for (int d0 = 0; d0 < 4; ++d0) qf[d0] = qn[d0]; }
}

template <int NH, bool MASKED>
__device__ __forceinline__ void sm_unit(LAS unsigned char* lds, int& pb, TileRegs& tr, bf16x8 (&qf)[4], const UDesc& nxt, const bf16* K, const bf16* V, int kvpitch, long ktok0, int kstride,
                                        int jt0, int irow, float slope2d, bf16* orow, float* lserow, int tid) {
    const int lane = tid & 63, r32 = lane & 31, hi = lane >> 5, wid = __builtin_amdgcn_readfirstlane(tid >> 6);
    const int h2 = (NH == 2) ? (wid >> 2) : 0, i0 = (NH == 2) ? (wid & 3) * 32 : wid * 32;
    f32x16 o[2]; o[0] = f32x16{}; o[1] = f32x16{};
    float m = -1e30f, lsum = 0.f;
    TileRegs nx; bf16x8 qn[4];
    tile_store<NH>(tr, lds + pb * BUF_BYTES, tid);
    if (jt0 < 3) tile_load<NH>(tr, K, V, kvpitch, ktok0 + (long)(jt0 + 1) * 64 * kstride, kstride, tid);
    unit_prefetch(nx, qn, nxt, tid);
    __syncthreads();
#pragma unroll 1
    for (int jt = jt0; jt < 4; ++jt) {
        const LAS unsigned char* cur = lds + pb * BUF_BYTES;
        if (jt < 3) { tile_store<NH>(tr, lds + (pb ^ 1) * BUF_BYTES, tid); if (jt < 2) tile_load<NH>(tr, K, V, kvpitch, ktok0 + (long)(jt + 2) * 64 * kstride, kstride, tid); }
        const int j0 = jt * 64;
        const bool active = !MASKED || ((j0 + 63 >= i0) && (j0 <= i0 + 159));
        if (active) {
            f32x16 p[2];
            st_tile<MASKED>(p, cur + h2 * HEAD_BYTES, qf, r32, hi, slope2d * (float)(j0 + 4 * hi), slope2d);
            if (MASKED && !((j0 >= i0 + 31) && (j0 + 63 <= i0 + 128))) {
                const int jb = j0 + 4 * hi - irow;
#pragma unroll
                for (int kh = 0; kh < 2; ++kh)
#pragma unroll
                    for (int r = 0; r < 16; ++r) { const int dj = jb + kh * 32 + 8 * (r >> 2) + (r & 3); if ((unsigned)dj > 128u) p[kh][r] = -1e30f; }
            }
            float tm = p[0][0];
#pragma unroll
            for (int kh = 0; kh < 2; ++kh)
#pragma unroll
                for (int r = 0; r < 16; ++r) tm = __builtin_fmaxf(tm, p[kh][r]);
            tm = __builtin_fmaxf(tm, __shfl_xor(tm, 32));
            const float mn = __builtin_fmaxf(m, tm), al = ex2(m - mn); m = mn;
            float s = 0.f;
#pragma unroll
            for (int kh = 0; kh < 2; ++kh)
#pragma unroll
                for (int r = 0; r < 16; ++r) { const float e = ex2(p[kh][r] - mn); p[kh][r] = e; s += e; }
            lsum = lsum * al + s;
#pragma unroll
            for (int dh = 0; dh < 2; ++dh)
#pragma unroll
                for (int r = 0; r < 16; ++r) o[dh][r] *= al;
            pv_tile(o, cur + h2 * HEAD_BYTES + KT_BYTES, p, lane);
        }
        __syncthreads();
        pb ^= 1;
    }
    const float lt = lsum + __shfl_xor(lsum, 32);
    store_o(orow, o, __builtin_amdgcn_rcpf(lt), hi);
    if (lserow && hi == 0) *lserow = m + lg2(lt) - slope2d * (float)(irow + 128);
    if (nxt.q) { tr = nx;
#pragma unroll
        for (int d0 = 0; d0 < 4; ++d0) qf[d0] = qn[d0]; }
}
}
#define XB_TMO      128
#define XB_XCNT(j)  (256  + 64 * (j))
#define XB_XSUB(j)  (1280 + 64 * (j))
#define XB_XGEN(j)  (2304 + 64 * (j))
#define XB_TOP      3328
#define XB_TOPGEN   3392
#define XCD_BAR_WORDS 3456
#define XB_SPIN_CAP (1u << 18)

__device__ __forceinline__ unsigned xb_ld(unsigned* p)              { return __hip_atomic_load(p, __ATOMIC_RELAXED, __HIP_MEMORY_SCOPE_AGENT); }
__device__ __forceinline__ unsigned xb_add(unsigned* p, unsigned v) { return __hip_atomic_fetch_add(p, v, __ATOMIC_RELAXED, __HIP_MEMORY_SCOPE_AGENT); }
__device__ __forceinline__ unsigned xb_xcc_id() { return (unsigned)__builtin_amdgcn_s_getreg((3 << 11) | 20) & 0xFu; }
#define XB_SPIN(cond, bar) do { unsigned _sp = 0; while (cond) { __builtin_amdgcn_s_sleep(1); \
    if ((++_sp & 255u) == 0u) { if (xb_ld(&(bar)[XB_TMO])) break; if (_sp > XB_SPIN_CAP) { atomicAdd(&(bar)[XB_TMO], 1u); break; } } } } while (0)

struct XcdBarrier {
    unsigned* bar; unsigned x;
    volatile LAS unsigned* st;
};

__device__ __forceinline__ XcdBarrier xcd_barrier_post(unsigned* bar, volatile LAS unsigned* st) {
    XcdBarrier b; b.bar = bar; b.x = xb_xcc_id(); b.st = st;
    if (threadIdx.x == 0) (void)xb_add(&bar[XB_XCNT(b.x)], 1u);
    return b;
}
__device__ __forceinline__ void xcd_barrier_complete(unsigned* bar, unsigned x, unsigned& nloc, unsigned& nx) {
    const unsigned G = gridDim.x * gridDim.y * gridDim.z;
    unsigned sum, cnt, mine, sp = 0u;
    for (;;) {
        sum = 0u; cnt = 0u; mine = 0u;
#pragma unroll
        for (unsigned j = 0; j < 16; ++j) { const unsigned c = xb_ld(&bar[XB_XCNT(j)]); sum += c; cnt += (c > 0u) ? 1u : 0u; mine = (j == x) ? c : mine; }
        if (sum == G) break;
        __builtin_amdgcn_s_sleep(1);
        if ((++sp & 255u) == 0u) { if (xb_ld(&bar[XB_TMO])) break; if (sp > XB_SPIN_CAP) { atomicAdd(&bar[XB_TMO], 1u); break; } }
    }
    nloc = mine > 0u ? mine : 1u; nx = cnt > 0u ? cnt : 1u;
}

__device__ __forceinline__ void xcd_barrier(const XcdBarrier& b) {
    asm volatile("s_waitcnt vmcnt(0)" ::: "memory");
    __syncthreads();
    if (threadIdx.x == 0) {
        unsigned* bar = b.bar;
        __builtin_amdgcn_s_waitcnt(0);
        unsigned nloc = b.st[0], nx = b.st[1];
        if (nloc == 0u) { xcd_barrier_complete(bar, b.x, nloc, nx); b.st[0] = nloc; b.st[1] = nx; }
        const unsigned old = xb_add(&bar[XB_XSUB(b.x)], 1u);
        const unsigned gen = old / nloc;
        if (old + 1u == (gen + 1u) * nloc) {
            __builtin_amdgcn_fence(__ATOMIC_RELEASE, "agent");
            asm volatile("s_waitcnt vmcnt(0)" ::: "memory");
            const unsigned og = xb_add(&bar[XB_TOP], 1u);
            const unsigned tg = og / nx;
            if (og + 1u == (tg + 1u) * nx) xb_add(&bar[XB_TOPGEN], 1u);
            else XB_SPIN(xb_ld(&bar[XB_TOPGEN]) == tg, bar);
            __builtin_amdgcn_fence(__ATOMIC_ACQUIRE, "agent");
            xb_add(&bar[XB_XGEN(b.x)], 1u);
            asm volatile("s_waitcnt vmcnt(0)" ::: "memory");
        } else {
            XB_SPIN(xb_ld(&bar[XB_XGEN(b.x)]) == gen, bar);
            __builtin_amdgcn_fence(__ATOMIC_ACQUIRE, "agent");
            asm volatile("s_waitcnt vmcnt(0)" ::: "memory");
        }
    }
    __syncthreads();
}

#ifndef PROBE_FLAGS
#define PROBE_FLAGS 0
#endif
#ifndef REP_MASK
#define REP_MASK 0
#endif
#ifndef MK_ONE_LAUNCH
#define MK_ONE_LAUNCH 1
#endif
constexpr int N_PHASES = 15;
struct Args { const void* in[23]; float* out; unsigned char* ws; int ph_lo, ph_hi, flags, pad; };
static_assert(sizeof(Args) == 23 * 8 + 8 + 8 + 16, "Args has no padding");

__device__ __forceinline__ void transpose_item(const float* W, int K, int N, bf16* WT, int k0, int n0, int drow0, const float* gain, float cscale, LAS float* scr, int lane) {
#pragma unroll 8
    for (int i = 0; i < 32; ++i) { const int kk = 2 * i + (lane >> 5); const float g = gain ? gain[k0 + kk] * cscale : cscale; scr[kk * 33 + (lane & 31)] = W[(size_t)(k0 + kk) * N + n0 + (lane & 31)] * g; }
    asm volatile("s_waitcnt lgkmcnt(0)" ::: "memory");
    const int c = lane & 7;
#pragma unroll
    for (int j = 0; j < 4; ++j) { const int n = (lane >> 3) + 8 * j; const LAS float* s = scr + (8 * c) * 33 + n;
        u32x4 o; o.x = cvtpk(s[0 * 33], s[1 * 33]); o.y = cvtpk(s[2 * 33], s[3 * 33]); o.z = cvtpk(s[4 * 33], s[5 * 33]); o.w = cvtpk(s[6 * 33], s[7 * 33]);
        *(u32x4*)(WT + (size_t)(drow0 + n) * K + k0 + 8 * c) = o; }
    asm volatile("s_waitcnt lgkmcnt(0)" ::: "memory");
}
template <int NR> __device__ __forceinline__ void row_prep(const float* xrow, bf16* orow, float* ssp, int lane) {
    f32x4 v[NR][4]; float s[NR];
#pragma unroll
    for (int r = 0; r < NR; ++r)
#pragma unroll
        for (int j = 0; j < 4; ++j) v[r][j] = __builtin_nontemporal_load((const f32x4*)(xrow + (size_t)r * D) + lane + 64 * j);
#pragma unroll
    for (int r = 0; r < NR; ++r) { s[r] = 0.f;
#pragma unroll
        for (int j = 0; j < 4; ++j) s[r] += (v[r][j][0] * v[r][j][0] + v[r][j][1] * v[r][j][1]) + (v[r][j][2] * v[r][j][2] + v[r][j][3] * v[r][j][3]);
        s[r] = wave_sum(s[r]);
        u32x2* o8 = (u32x2*)(orow + (size_t)r * D) + lane;
#pragma unroll
        for (int j = 0; j < 4; ++j) { u32x2 w; w.x = cvtpk(v[r][j][0], v[r][j][1]); w.y = cvtpk(v[r][j][2], v[r][j][3]); o8[64 * j] = w; }
        if (lane < 16) ssp[r * 16 + lane] = (lane == 0) ? s[r] : 0.f; }
}

__global__ void __launch_bounds__(NTHREADS, 2) yoco_fwd(Args args) {
    extern __shared__ __attribute__((aligned(16))) unsigned char lds_raw[];
    LAS unsigned char* lds = (LAS unsigned char*)lds_raw;
    const int tid = threadIdx.x, lane = tid & 63, wave = __builtin_amdgcn_readfirstlane(tid >> 6);
    const int G = gridDim.x, bx = blockIdx.x;
    const int gw = bx * NWAVES + wave, NGW = G * NWAVES;
    unsigned char* ws = args.ws;
    const float* x = (const float*)args.in[0]; const float* mem = (const float*)args.in[1];
    float* out = args.out;
    bf16* W1 = (bf16*)(ws + WS_W1); bf16* W3 = (bf16*)(ws + WS_W3); bf16* WM = (bf16*)(ws + WS_WM); bf16* W4 = (bf16*)(ws + WS_W4); bf16* W5 = (bf16*)(ws + WS_W5);
    bf16* W6 = (bf16*)(ws + WS_W6); bf16* W8 = (bf16*)(ws + WS_W8); bf16* W9 = (bf16*)(ws + WS_W9); bf16* W10 = (bf16*)(ws + WS_W10);
    float* CWP = (float*)(ws + WS_CWP);
    float* SSPX = (float*)(ws + WS_SSPX); float* SSP1 = (float*)(ws + WS_SSP1); float* SSP2 = (float*)(ws + WS_SSP2); float* SSP3 = (float*)(ws + WS_SSP3); float* SSP4 = (float*)(ws + WS_SSP4); float* SSPM = (float*)(ws + WS_SSPM);
    float* LSE = (float*)(ws + WS_LSE); float* SIDE = (float*)(ws + WS_SIDE);
    bf16* MEMB = (bf16*)(ws + WS_MEMB); bf16* MEMKV = (bf16*)(ws + WS_MEMKV); bf16* HB = (bf16*)(ws + WS_HB); bf16* PROJ = (bf16*)(ws + WS_PROJ); bf16* ATT = (bf16*)(ws + WS_ATT); bf16* ACT = (bf16*)(ws + WS_ACT);
    const int lo = args.ph_lo, hi_ph = args.ph_hi;
    XcdBarrier xbar; xbar.bar = (unsigned*)(ws + WS_CTL); xbar.x = 0; xbar.st = nullptr;
    if (hi_ph - lo > 1) {
        volatile LAS unsigned* st = (volatile LAS unsigned*)(lds + LDS_MISC_OFF); if (tid < 2) st[tid] = 0u; __syncthreads();
        xbar = xcd_barrier_post((unsigned*)(ws + WS_CTL), st); }
    if (args.flags < 0) cg::this_grid().sync();
#define IN(k) (lo <= (k) && (k) < hi_ph)
#define SEAM(k) do { if (IN(k) && IN((k) + 1)) { xcd_barrier(xbar); } } while (0)

    if (IN(0)) {
        LAS float* scr = (LAS float*)(lds + wave * 16384);
        int base = 0;
#define DO_W(SRC, KK, NN, GAIN, KIND, DST, ROFF) do { constexpr int nblk = (NN) / 32, cnt = ((KK) / 64) * nblk; \
            const float* W = (const float*)args.in[SRC]; const float* gain = (GAIN) >= 0 ? (const float*)args.in[(GAIN) >= 0 ? (GAIN) : 0] : nullptr; bf16* WT = (bf16*)(ws + (DST)); \
            const int first = (gw - base % NGW + NGW) % NGW; \
            for (int r = first; r < cnt; r += NGW) { const int kb = r / nblk, nb = r % nblk, k0 = 64 * kb, n0 = 32 * nb; float cs = 1.f; int drow0 = (ROFF) + n0; \
                if ((KIND) == 1) cs = (n0 < 768 || n0 >= 2304) ? QS : 1.f; else if ((KIND) == 2) cs = QS; \
                else if ((KIND) == 3) { const int half = n0 / DFF, j = n0 % DFF; drow0 = 256 * (j / 128) + 128 * half + (j % 128); } \
                transpose_item(W, (KK), (NN), WT, k0, n0, drow0, gain, cs, scr, lane); } \
            base += cnt; } while (0)
        DO_W(3, D, NPROJ, 2, 1, WS_W1, 0); DO_W(4, D, D, -1, 0, WS_W3, 0); DO_W(6, D, 512, 5, 0, WS_WM, 0); DO_W(17, D, 512, 16, 0, WS_WM, 512);
        DO_W(8, D, NUP, 7, 3, WS_W4, 0); DO_W(10, DFF, D, -1, 0, WS_W5, 0); DO_W(12, D, 1536, 11, 0, WS_W6, 0); DO_W(14, D, D, 13, 2, WS_W6, 1536);
        DO_W(15, D, D, -1, 0, WS_W8, 0); DO_W(19, D, NUP, 18, 3, WS_W9, 0); DO_W(21, DFF, D, -1, 0, WS_W10, 0);
#undef DO_W
        for (int i = bx * NTHREADS + tid; i < 2 * 3 * NUP; i += G * NTHREADS) { const int layer = i / (3 * NUP), r = i % (3 * NUP), k = r / NUP, cn = r % NUP, pn = cn / 256, half = (cn >> 7) & 1, cc = cn & 127;
            const float* cv = (const float*)args.in[layer == 0 ? 9 : 20]; CWP[i] = cv[k * NUP + half * DFF + 128 * pn + cc]; }
        for (int m = gw * 4; m < MTOK + MMEM; m += NGW * 4) {
            if (m < MTOK) row_prep<4>(x + (size_t)m * D, HB + (size_t)m * D, SSPX + (size_t)m * 16, lane);
            else { const int r = m - MTOK; row_prep<4>(mem + (size_t)r * D, MEMB + (size_t)r * D, SSPM + (size_t)r * 16, lane); }
        }
    }
    SEAM(0);
    if (IN(1)) {
        { pg8::Gemm g{HB, W1, MTOK, NPROJ, D}; pg8::StaticOrder S; S.init(MTOK, NPROJ, G, bx); pg8::EpiScaleBf16 E{PROJ, NPROJ, SSPX};
          pg8::gemm_phase<pg8::EpiScaleBf16, pg8::StaticOrder, true, true>(lds, g, S, E); }
        { pg8::Gemm g{MEMB, WM, MMEM, D, D}; pg8::StaticOrder S; S.init(MMEM, D, G, (bx + 128) % G); pg8::EpiScaleBf16 E{MEMKV, D, SSPM};
          pg8::gemm_phase<pg8::EpiScaleBf16, pg8::StaticOrder, true, true>(lds, g, S, E); }
    }
    SEAM(1);
    if (IN(2)) {
#define P2_DESC(dd, uu) do { const int u_ = (uu); if (u_ >= 4096) { (dd).q = nullptr; } else if (u_ < 3072) { const int bh_ = u_ >> 3, qb_ = ((u_ & 7) + (u_ >> 8)) & 7, b_ = bh_ / 12, h_ = bh_ % 12; \
                const size_t tok_ = (size_t)b_ * SEQ + qb_ * 256 + wave * 32 + (lane & 31); (dd).q = PROJ + tok_ * NPROJ + h_ * 64; (dd).K = PROJ + 768 + h_ * 64; (dd).V = PROJ + 1536 + h_ * 64; (dd).pitch = NPROJ; \
                (dd).tok0 = (long)b_ * SEQ + (qb_ * 4 + 3) * 64; (dd).tstride = 1; (dd).nh = 1; } \
            else { const int v_ = u_ - 3072, b_ = v_ >> 5, hm_ = (v_ >> 3) & 3, qb_ = v_ & 7; const size_t tok_ = (size_t)b_ * SEQ + qb_ * 256 + wave * 32 + (lane & 31); \
                (dd).q = PROJ + tok_ * NPROJ + 2304 + hm_ * 64; (dd).K = MEMKV + hm_ * 64; (dd).V = MEMKV + 256 + hm_ * 64; (dd).pitch = D; (dd).tok0 = (long)b_ * MEML; (dd).tstride = 1; (dd).nh = 1; } } while (0)
        att::TileRegs tr; bf16x8 qf[4]; att::UDesc dn; int pb = 0;
        P2_DESC(dn, bx); att::unit_prefetch(tr, qf, dn, tid);
        for (int u = bx; u < 4096; u += G) {
            P2_DESC(dn, u + G);
            if (u < 3072) { const int bh = u >> 3, qb = ((u & 7) + (u >> 8)) & 7; att::sb_unit(lds, pb, tr, qf, dn, PROJ, ATT, bh / 12, bh % 12, qb, tid); }
            else { const int v = u - 3072, b = v >> 5, hm = (v >> 3) & 3, qb = v & 7; const size_t tok = (size_t)b * SEQ + qb * 256 + wave * 32 + (lane & 31);
                att::sm_unit<1, false>(lds, pb, tr, qf, dn, MEMKV + hm * 64, MEMKV + 256 + hm * 64, D, (long)b * MEML, 1, 0, 0, 0.f, ATT + tok * D + 768 + hm * 64, nullptr, tid); }
        }
#undef P2_DESC
    }
    SEAM(2);
    if (IN(3)) { pg8::Gemm g{ATT, W3, MTOK, D, D}; pg8::StaticOrder S; S.init(MTOK, D, G, bx); pg8::EpiResid E{HB, HB, nullptr, SSP1};
        pg8::gemm_phase<pg8::EpiResid, pg8::StaticOrder, true, true>(lds, g, S, E); }
    SEAM(3);
    if (IN(4)) { pg8::Gemm g{HB, W4, MTOK, NUP, D}; pg8::StaticOrder S; S.init(MTOK, NUP, G, bx); pg8::EpiConvGate E{ACT, SSP1, CWP, SIDE, (PG8_LAS pg8::f32x4*)(lds + LDS_X_OFF)};
        pg8::gemm_phase<pg8::EpiConvGate, pg8::StaticOrder, true, true>(lds, g, S, E); }
    SEAM(4);
#define FIXUP(cwl) do { const float* cw_ = (cwl); \
        for (int i = bx * NTHREADS + tid; i < 256 * 2 * (DFF / 4); i += G * NTHREADS) { const int pm = i / (2 * (DFF / 4)), r = i % (2 * (DFF / 4)), t = r / (DFF / 4), j = (r % (DFF / 4)) * 4, cn = 256 * (j >> 7) + (j & 127); \
            f32x4 c2[2]; \
            _Pragma("unroll") for (int hf = 0; hf < 2; ++hf) { const int c = cn + 128 * hf; const float* sd = SIDE + (size_t)pm * 4 * NUP + c; \
                const f32x4 u0 = *(const f32x4*)sd, u1 = *(const f32x4*)(sd + NUP); f32x4 um1 = {0.f, 0.f, 0.f, 0.f}, um2 = {0.f, 0.f, 0.f, 0.f}; if (pm & 7) { um2 = *(const f32x4*)(sd - 2 * NUP); um1 = *(const f32x4*)(sd - NUP); } \
                const f32x4 w0 = *(const f32x4*)(cw_ + c), w1 = *(const f32x4*)(cw_ + NUP + c), w2 = *(const f32x4*)(cw_ + 2 * NUP + c); \
                c2[hf] = (t == 0) ? (w2 * u0 + w1 * um1 + w0 * um2) : (w2 * u1 + w1 * u0 + w0 * um1); } \
            f32x4 o_; \
            _Pragma("unroll") for (int e = 0; e < 4; ++e) { const float g = c2[1][e], sg = g * __builtin_amdgcn_rcpf(1.f + ex2(-LOG2E * g)); o_[e] = c2[0][e] * sg; } \
            u32x2 pk; pk.x = cvtpk(o_[0], o_[1]); pk.y = cvtpk(o_[2], o_[3]); *(u32x2*)(ACT + (size_t)(pm * 256 + t) * DFF + j) = pk; } } while (0)
    if (IN(5)) FIXUP(CWP);
    SEAM(5);
    if (IN(6)) { pg8::Gemm g{ACT, W5, MTOK, D, DFF}; pg8::StaticOrder S; S.init(MTOK, D, G, bx); pg8::EpiResid E{HB, HB, nullptr, SSP2};
        pg8::gemm_phase<pg8::EpiResid, pg8::StaticOrder, true, true>(lds, g, S, E); }
    SEAM(6);
    if (IN(7)) { pg8::Gemm g{HB, W6, MTOK, NPROJ, D}; pg8::StaticOrder S; S.init(MTOK, NPROJ, G, bx); pg8::EpiScaleBf16 E{PROJ, NPROJ, SSP2};
        pg8::gemm_phase<pg8::EpiScaleBf16, pg8::StaticOrder, true, true>(lds, g, S, E); }
    SEAM(7);
    if (IN(8)) {
#define P8_DEC(uu) const int hp_ = (uu) & 1, rn_ = ((uu) >> 1) & 15, g_ = ((uu) >> 5) % 3, b_ = (uu) / 96; \
            const int d_ = (g_ == 0) ? 1 : (g_ == 1) ? 4 : 16, res_ = (g_ == 0) ? 0 : (g_ == 1) ? (rn_ >> 2) : rn_, n_ = (g_ == 0) ? rn_ : (g_ == 1) ? (rn_ & 3) : 0; \
            const int head_ = g_ * 4 + hp_ * 2 + (wave >> 2), i_ = (wave & 3) * 32 + (lane & 31), jt0_ = (n_ == 0) ? 2 : 0; \
            const size_t tok_ = (size_t)b_ * SEQ + (size_t)(n_ * 128 + i_) * d_ + res_; const long ktok0_ = (long)b_ * SEQ + (long)(n_ - 1) * 128 * d_ + res_; \
            const bf16* Kp_ = PROJ + (g_ * 4 + hp_ * 2) * 64; const bf16* Vp_ = Kp_ + 768;
#define P8_DESC(dd, uu) do { const int u_ = (uu); if (u_ >= 4096) { (dd).q = nullptr; } else if (u_ < 3072) { P8_DEC(u_) \
                (dd).q = PROJ + tok_ * NPROJ + 1536 + head_ * 64; (dd).K = Kp_; (dd).V = Vp_; (dd).pitch = NPROJ; (dd).tok0 = ktok0_ + (long)jt0_ * 64 * d_; (dd).tstride = d_; (dd).nh = 2; } \
            else { const int v_ = u_ - 3072, b_ = v_ >> 5, hm_ = (v_ >> 3) & 3, qb_ = v_ & 7; const size_t tok_ = (size_t)b_ * SEQ + qb_ * 256 + wave * 32 + (lane & 31); \
                (dd).q = PROJ + tok_ * NPROJ + 2304 + hm_ * 64; (dd).K = MEMKV + 512 + hm_ * 64; (dd).V = MEMKV + 768 + hm_ * 64; (dd).pitch = D; (dd).tok0 = (long)b_ * MEML; (dd).tstride = 1; (dd).nh = 1; } } while (0)
        att::TileRegs tr; bf16x8 qf[4]; att::UDesc dn; int pb = 0;
        P8_DESC(dn, bx); att::unit_prefetch(tr, qf, dn, tid);
        for (int u = bx; u < 4096; u += G) {
            P8_DESC(dn, u + G);
            if (u < 3072) { P8_DEC(u)
                const float slope2d = ex2(-8.f * (float)(head_ + 1) / 12.f) * LOG2E * (float)d_;
                att::sm_unit<2, true>(lds, pb, tr, qf, dn, Kp_, Vp_, NPROJ, ktok0_, d_, jt0_, i_, slope2d, ATT + tok_ * D + head_ * 64, LSE + tok_ * 12 + head_, tid); }
            else { const int v = u - 3072, b = v >> 5, hm = (v >> 3) & 3, qb = v & 7; const size_t tok = (size_t)b * SEQ + qb * 256 + wave * 32 + (lane & 31);
                att::sm_unit<1, false>(lds, pb, tr, qf, dn, MEMKV + 512 + hm * 64, MEMKV + 768 + hm * 64, D, (long)b * MEML, 1, 0, 0, 0.f, ATT + tok * D + 768 + hm * 64, nullptr, tid); }
        }
#undef P8_DESC
#undef P8_DEC
    }
    SEAM(8);
    if (IN(9)) {
        for (int i0 = bx * NTHREADS + tid; i0 < MTOK * 96; i0 += 4 * G * NTHREADS) {
            u32x4 v[4]; float al[4];
#pragma unroll
            for (int k = 0; k < 4; ++k) { const int i = i0 + k * G * NTHREADS; if (i < MTOK * 96) v[k] = *(const u32x4*)(ATT + (size_t)(i / 96) * D + (i % 96) * 8); }
#pragma unroll
            for (int k = 0; k < 4; ++k) { const int i = i0 + k * G * NTHREADS; al[k] = 0.f; if (i < MTOK * 96) { const int row = i / 96, head = (i % 96) >> 3, hg = head & 3;
                const float* ls = LSE + (size_t)row * 12 + hg; const float l0 = ls[0], l1 = ls[4], l2 = ls[8], mx = __builtin_fmaxf(l0, __builtin_fmaxf(l1, l2));
                const float e0 = ex2(l0 - mx), e1 = ex2(l1 - mx), e2 = ex2(l2 - mx); const float mine = (head < 4) ? e0 : (head < 8) ? e1 : e2; al[k] = mine * __builtin_amdgcn_rcpf(e0 + e1 + e2); } }
#pragma unroll
            for (int k = 0; k < 4; ++k) { const int i = i0 + k * G * NTHREADS; if (i < MTOK * 96) { u32x4 w = v[k];
#pragma unroll
                for (int e = 0; e < 4; ++e) { const float a = __uint_as_float(w[e] << 16) * al[k], b2 = __uint_as_float(w[e] & 0xffff0000u) * al[k]; w[e] = cvtpk(a, b2); }
                *(u32x4*)(ATT + (size_t)(i / 96) * D + (i % 96) * 8) = w; } }
        }
    }
    SEAM(9);
    if (IN(10)) { pg8::Gemm g{ATT, W8, MTOK, D, D}; pg8::StaticOrder S; S.init(MTOK, D, G, bx); pg8::EpiResid E{HB, HB, nullptr, SSP3};
        pg8::gemm_phase<pg8::EpiResid, pg8::StaticOrder, true, true>(lds, g, S, E); }
    SEAM(10);
    if (IN(11)) { pg8::Gemm g{HB, W9, MTOK, NUP, D}; pg8::StaticOrder S; S.init(MTOK, NUP, G, bx); pg8::EpiConvGate E{ACT, SSP3, CWP + 3 * NUP, SIDE, (PG8_LAS pg8::f32x4*)(lds + LDS_X_OFF)};
        pg8::gemm_phase<pg8::EpiConvGate, pg8::StaticOrder, true, true>(lds, g, S, E); }
    SEAM(11);
    if (IN(12)) FIXUP(CWP + 3 * NUP);
    SEAM(12);
    if (IN(13)) { pg8::Gemm g{ACT, W10, MTOK, D, DFF}; pg8::StaticOrder S; S.init(MTOK, D, G, bx); pg8::EpiResid E{HB, HB, nullptr, SSP4};
        pg8::gemm_phase<pg8::EpiResid, pg8::StaticOrder, true, true>(lds, g, S, E); }
    SEAM(13);
    if (IN(14)) {
        const float* fn = (const float*)args.in[22];
        const f32x4* gp = (const f32x4*)fn;
        for (int m0 = gw * 4; m0 < MTOK; m0 += NGW * 4) {
            u32x4 b[4][2]; float rs[4];
#pragma unroll
            for (int r = 0; r < 4; ++r) { const u32x4* hp = (const u32x4*)(HB + (size_t)(m0 + r) * D) + lane; b[r][0] = __builtin_nontemporal_load(hp); b[r][1] = __builtin_nontemporal_load(hp + 64); }
#pragma unroll
            for (int r = 0; r < 4; ++r) rs[r] = pg8::row_rstd(SSP4, m0 + r);
#pragma unroll
            for (int r = 0; r < 4; ++r) { f32x4* o = (f32x4*)(out + (size_t)(m0 + r) * D);
#pragma unroll
                for (int j = 0; j < 2; ++j) { const u32x4 bb = b[r][j]; const int c4 = (64 * j + lane) * 2; const f32x4 g0 = gp[c4], g1 = gp[c4 + 1]; f32x4 v0, v1;
                    v0[0] = __uint_as_float(bb.x << 16); v0[1] = __uint_as_float(bb.x & 0xffff0000u); v0[2] = __uint_as_float(bb.y << 16); v0[3] = __uint_as_float(bb.y & 0xffff0000u);
                    v1[0] = __uint_as_float(bb.z << 16); v1[1] = __uint_as_float(bb.z & 0xffff0000u); v1[2] = __uint_as_float(bb.w << 16); v1[3] = __uint_as_float(bb.w & 0xffff0000u);
                    __builtin_nontemporal_store(v0 * rs[r] * g0, o + c4); __builtin_nontemporal_store(v1 * rs[r] * g1, o + c4 + 1); } } }
    }
#undef IN
#undef SEAM
#undef FIXUP
}

extern "C" void kernel_launch(void* const* d_in, const int* in_sizes, int n_in, void* d_out, int out_size, void* d_ws, size_t ws_size, hipStream_t stream) {
    static int grid = 0;
    if (grid == 0) {
        if (n_in != 23 || in_sizes[0] != MTOK * D || out_size != MTOK * D || ws_size < WS_END) { fprintf(stderr, "kernel_launch: unexpected shapes (n_in %d, in0 %d, out %d, ws %zu)\n", n_in, n_in > 0 ? in_sizes[0] : -1, out_size, ws_size); grid = -1; return; }
        int dev = 0, cus = 0, per_cu = 0;
        if (hipGetDevice(&dev) != hipSuccess || hipDeviceGetAttribute(&cus, hipDeviceAttributeMultiprocessorCount, dev) != hipSuccess) { grid = -1; return; }
        if (hipFuncSetAttribute((const void*)yoco_fwd, hipFuncAttributeMaxDynamicSharedMemorySize, LDS_BYTES) != hipSuccess) { fprintf(stderr, "kernel_launch: hipFuncSetAttribute failed\n"); grid = -1; return; }
        if (hipOccupancyMaxActiveBlocksPerMultiprocessor(&per_cu, (const void*)yoco_fwd, NTHREADS, LDS_BYTES) != hipSuccess || per_cu < 1) { fprintf(stderr, "kernel_launch: occupancy query gave %d\n", per_cu); per_cu = 1; }
        (void)hipGetLastError();
        grid = cus * per_cu;
    }
    if (grid < 0) return;
    if (hipMemsetAsync((char*)d_ws + WS_CTL, 0, CTL_BYTES, stream) != hipSuccess) { fprintf(stderr, "kernel_launch: memset of barrier words failed\n"); return; }
    Args a{};
    for (int i = 0; i < 23; ++i) a.in[i] = d_in[i];
    a.out = (float*)d_out; a.ws = (unsigned char*)d_ws;
#if MK_ONE_LAUNCH
    a.ph_lo = 0; a.ph_hi = N_PHASES;
    void* kargs[] = {&a};
    hipError_t e = hipLaunchCooperativeKernel((const void*)yoco_fwd, dim3(grid), dim3(NTHREADS), kargs, LDS_BYTES, stream);
    if (e != hipSuccess) fprintf(stderr, "kernel_launch: cooperative launch failed: %s (grid %d)\n", hipGetErrorString(e), grid);
#else
    for (int p = 0; p < N_PHASES; ++p) { a.ph_lo = p; a.ph_hi = p + 1; const int reps = ((REP_MASK >> p) & 1) ? 2 : 1;
        for (int r = 0; r < reps; ++r) { a.flags = (r + 1 < reps) ? PROBE_FLAGS : 0; hipLaunchKernelGGL(yoco_fwd, dim3(grid), dim3(NTHREADS), LDS_BYTES, stream, a); } }
#endif
}
```

```cpp
#include <hip/hip_runtime.h>
#include <hip/hip_cooperative_groups.h>
#include <cstdio>
#include <cstdint>
namespace cg = cooperative_groups;
namespace pg8 {
#define PG8_LAS __attribute__((address_space(3)))
typedef unsigned short bf16_t;
typedef short bf16x8 __attribute__((ext_vector_type(8)));
typedef float f32x4 __attribute__((ext_vector_type(4)));
typedef unsigned u32x4 __attribute__((ext_vector_type(4)));
constexpr int BM = 256, BK = 64, HALF = 128, HTB = HALF * BK * 2  , STAGE_BYTES = 8 * HTB, NXCD = 8, WGM = 8;

__host__ __device__ __forceinline__ int lds_byte(int r, int c) { const int st = (r >> 4) * 2 + (c >> 5), rr = r & 15, cc = c & 31, ob = rr * 64 + cc * 2; return st * 1024 + (ob ^ (((ob >> 9) & 1) << 5)); }
__host__ __device__ __forceinline__ void stage_rc(int b, int& R, int& C) { const int st = b / 1024, sb = b % 1024, swz = sb ^ (((sb >> 9) & 1) << 5); R = (st >> 1) * 16 + swz / 64; C = (st & 1) * 32 + (swz % 64) / 2; }
__host__ __device__ __forceinline__ int perm32(int rho) { const int n = rho >> 4, i = rho & 15; return 8 * (i >> 2) + 4 * n + (i & 3); }

struct Unit { int pm, pn; };
struct Gemm { const bf16_t* A; const bf16_t* Bt; int M, N, K; };

struct StaticOrder {
    int nM, nN, nwg, G, c;
    __host__ __device__ void init(int M, int N, int G_, int c_) { nM = M / BM; nN = N / BM; nwg = nM * nN; G = G_; c = c_; }
    __host__ __device__ bool next(int i, Unit& u) const {
        const long L = (long)i * G + c; if (L >= nwg) return false;
        int wgid = (int)L; { const int q = nwg / NXCD, r = nwg % NXCD, xcd = wgid % NXCD, off = wgid / NXCD; wgid = (xcd < r ? xcd * (q + 1) : r * (q + 1) + (xcd - r) * q) + off; }
        const int nig = WGM * nN, gid = wgid / nig, fm = gid * WGM, gsz = (nM - fm) < WGM ? (nM - fm) : WGM;
        u.pm = fm + ((wgid % nig) % gsz); u.pn = (wgid % nig) / gsz; return true;
    }
    __device__ __forceinline__ void a_ready(const Unit&) const {}
    __device__ __forceinline__ void done(const Unit&) const {}
};
__device__ __forceinline__ unsigned cvt_pk_bf16(float lo, float hi) { unsigned r; asm volatile("v_cvt_pk_bf16_f32 %0, %1, %2" : "=v"(r) : "v"(lo), "v"(hi)); return r; }
typedef float f32x2 __attribute__((ext_vector_type(2)));
typedef unsigned u32x2 __attribute__((ext_vector_type(2)));
constexpr float RMS_EPS = 1e-6f;
__device__ __forceinline__ float row_rstd(const float* ssp, int row) {
    const f32x4* p = (const f32x4*)(ssp + (size_t)row * 16);
    const f32x4 a = p[0], b = p[1], c = p[2], d = p[3];
    const float s = (((a[0] + a[1]) + (a[2] + a[3])) + ((b[0] + b[1]) + (b[2] + b[3]))) + (((c[0] + c[1]) + (c[2] + c[3])) + ((d[0] + d[1]) + (d[2] + d[3])));
    return __builtin_amdgcn_rsqf(s * (1.0f / 1024.0f) + RMS_EPS);
}
__device__ __forceinline__ void rows_rstd8(float (&rs)[2][4], const float* ssp, int row0, int fq) {
    f32x4 part[2][4];
#pragma unroll
    for (int ai = 0; ai < 2; ++ai)
#pragma unroll
        for (int m = 0; m < 4; ++m) part[ai][m] = *(const f32x4*)(ssp + (size_t)(row0 + ai * HALF + m * 16) * 16 + 4 * fq);
#pragma unroll
    for (int ai = 0; ai < 2; ++ai)
#pragma unroll
        for (int m = 0; m < 4; ++m) { float s = (part[ai][m][0] + part[ai][m][1]) + (part[ai][m][2] + part[ai][m][3]); s += __shfl_xor(s, 16); s += __shfl_xor(s, 32);
            rs[ai][m] = __builtin_amdgcn_rsqf(s * (1.0f / 1024.0f) + RMS_EPS); }
}
struct EpiScaleBf16 {
    static constexpr bool PERM = true, AFTER_DRAIN = false;
    bf16_t* O; int ldc; const float* ssp;
    __device__ __forceinline__ void operator()(const f32x4 (&acc)[2][2][4][2], const Unit& u, int wr, int wc, int fr, int fq) const {
        const int row0 = u.pm * BM + wr * 64 + fr, col0 = u.pn * BM + wc * 32 + 8 * fq;
        float rsv[2][4]; rows_rstd8(rsv, ssp, row0, fq);
#pragma unroll
        for (int ai = 0; ai < 2; ++ai)
#pragma unroll
            for (int m = 0; m < 4; ++m) { const int row = row0 + ai * HALF + m * 16; const float rs = rsv[ai][m]; bf16_t* rowp = O + (size_t)row * ldc + col0;
#pragma unroll
                for (int bj = 0; bj < 2; ++bj) { const f32x4 v0 = acc[ai][bj][m][0] * rs, v1 = acc[ai][bj][m][1] * rs;
                    u32x4 w; w.x = cvt_pk_bf16(v0[0], v0[1]); w.y = cvt_pk_bf16(v0[2], v0[3]); w.z = cvt_pk_bf16(v1[0], v1[1]); w.w = cvt_pk_bf16(v1[2], v1[3]);
                    *(u32x4*)(rowp + bj * HALF) = w; } }
    }
};
struct EpiResid {
    static constexpr bool PERM = true, AFTER_DRAIN = false;
    const bf16_t* base; bf16_t* hb; float* outf; float* ssp;
    __device__ __forceinline__ void operator()(const f32x4 (&acc)[2][2][4][2], const Unit& u, int wr, int wc, int fr, int fq) const {
        const int row0 = u.pm * BM + wr * 64 + fr, col0 = u.pn * BM + wc * 32 + 8 * fq;
#pragma unroll
        for (int ai = 0; ai < 2; ++ai) {
            u32x4 bs[4][2];
#pragma unroll
            for (int m = 0; m < 4; ++m)
#pragma unroll
                for (int bj = 0; bj < 2; ++bj) bs[m][bj] = *(const u32x4*)(base + (size_t)(row0 + ai * HALF + m * 16) * 1024 + col0 + bj * HALF);
#pragma unroll
            for (int m = 0; m < 4; ++m) { const int row = row0 + ai * HALF + m * 16; const size_t off = (size_t)row * 1024 + col0; float ss = 0.f;
#pragma unroll
                for (int bj = 0; bj < 2; ++bj) { const size_t o2 = off + bj * HALF; const u32x4 b = bs[m][bj];
                    f32x4 v0, v1;
                    v0[0] = __uint_as_float(b.x << 16); v0[1] = __uint_as_float(b.x & 0xffff0000u); v0[2] = __uint_as_float(b.y << 16); v0[3] = __uint_as_float(b.y & 0xffff0000u);
                    v1[0] = __uint_as_float(b.z << 16); v1[1] = __uint_as_float(b.z & 0xffff0000u); v1[2] = __uint_as_float(b.w << 16); v1[3] = __uint_as_float(b.w & 0xffff0000u);
                    v0 += acc[ai][bj][m][0]; v1 += acc[ai][bj][m][1];
                    ss += ((v0[0] * v0[0] + v0[1] * v0[1]) + (v0[2] * v0[2] + v0[3] * v0[3])) + ((v1[0] * v1[0] + v1[1] * v1[1]) + (v1[2] * v1[2] + v1[3] * v1[3]));
                    if (hb) { u32x4 w; w.x = cvt_pk_bf16(v0[0], v0[1]); w.y = cvt_pk_bf16(v0[2], v0[3]); w.z = cvt_pk_bf16(v1[0], v1[1]); w.w = cvt_pk_bf16(v1[2], v1[3]); *(u32x4*)(hb + o2) = w; }
                    if (outf) { *(f32x4*)(outf + o2) = v0; *(f32x4*)(outf + o2 + 4) = v1; } }
                ss += __shfl_xor(ss, 16); ss += __shfl_xor(ss, 32);
                if (fq == 0) ssp[(size_t)row * 16 + u.pn * 4 + wc] = ss; }
        }
    }
};
struct EpiConvGate {
    static constexpr bool PERM = true, AFTER_DRAIN = false;
    bf16_t* act; const float* ssp; const float* cw; float* side; PG8_LAS f32x4* X;
    __device__ __forceinline__ void operator()(const f32x4 (&acc)[2][2][4][2], const Unit& u, int wr, int wc, int fr, int fq) const {
        const int lane = threadIdx.x & 63, wid = wr * 4 + wc;
        const int rowb = u.pm * BM + wr * 64 + fr;
        float rs[2][4]; rows_rstd8(rs, ssp, rowb, fq);
        const int cn0 = u.pn * BM + wc * 32 + 8 * fq;
        if (fr >= 14) {
#pragma unroll
            for (int ai = 0; ai < 2; ++ai)
#pragma unroll
                for (int bj = 0; bj < 2; ++bj)
#pragma unroll
                    for (int n = 0; n < 2; ++n) { const f32x4 v = acc[ai][bj][3][n] * rs[ai][3];
                        X[((((wid * 2 + ai) * 2 + (fr - 14)) * 2 + bj) * 2 + n) * 4 + fq] = v;
                        if (ai == 1 && wr == 1) *(f32x4*)(side + ((size_t)u.pm * 4 + 2 + (fr - 14)) * 5632 + cn0 + bj * HALF + 4 * n) = v; }
        }
        if (wr == 0 && fr < 2) {
#pragma unroll
            for (int bj = 0; bj < 2; ++bj)
#pragma unroll
                for (int n = 0; n < 2; ++n) *(f32x4*)(side + ((size_t)u.pm * 4 + fr) * 5632 + cn0 + bj * HALF + 4 * n) = acc[0][bj][0][n] * rs[0][0];
        }
        asm volatile("s_waitcnt lgkmcnt(0)" ::: "memory"); __builtin_amdgcn_s_barrier(); asm volatile("" ::: "memory");
        const int fcol = u.pn * 128 + wc * 32 + 8 * fq;
        u32x2 keep[2][4];
#pragma unroll
        for (int n = 0; n < 2; ++n) {
            f32x4 w[3][2];
#pragma unroll
            for (int k = 0; k < 3; ++k)
#pragma unroll
                for (int bj = 0; bj < 2; ++bj) w[k][bj] = *(const f32x4*)(cw + k * 5632 + cn0 + bj * HALF + 4 * n);
#pragma unroll
            for (int ai = 0; ai < 2; ++ai) {
                const int q = 2 * ai + wr;
                f32x4 s1p[2], s2p[2];
                if (q == 0) { s1p[0] = s1p[1] = s2p[0] = s2p[1] = (f32x4){0.f, 0.f, 0.f, 0.f}; }
                else { const int pq = q - 1, pwid = (pq & 1) * 4 + wc, pai = pq >> 1;
#pragma unroll
                    for (int bj = 0; bj < 2; ++bj) { s1p[bj] = X[((((pwid * 2 + pai) * 2 + 1) * 2 + bj) * 2 + n) * 4 + fq]; s2p[bj] = X[((((pwid * 2 + pai) * 2 + (fr & 1)) * 2 + bj) * 2 + n) * 4 + fq]; } }
#pragma unroll
                for (int m = 0; m < 4; ++m) {
                    f32x4 c[2];
#pragma unroll
                    for (int bj = 0; bj < 2; ++bj) { const f32x4 cur = acc[ai][bj][m][n] * rs[ai][m]; f32x4 s1, s2;
#pragma unroll
                        for (int e = 0; e < 4; ++e) {
                            float a1, a2; const float ce = cur[e];
                            asm("s_nop 1\n\tv_mov_b32_dpp %0, %1 row_ror:1 row_mask:0xf bank_mask:0xf" : "=v"(a1) : "v"(ce));
                            asm("v_mov_b32_dpp %0, %1 row_ror:2 row_mask:0xf bank_mask:0xf" : "=v"(a2) : "v"(ce), "v"(a1));
                            s1[e] = a1; s2[e] = a2; }
                        const f32x4 p1 = (fr == 0) ? s1p[bj] : s1, p2 = (fr < 2) ? s2p[bj] : s2;
                        c[bj] = w[2][bj] * cur + w[1][bj] * p1 + w[0][bj] * p2; s1p[bj] = s1; s2p[bj] = s2; }
                    f32x4 o;
#pragma unroll
                    for (int e = 0; e < 4; ++e) { const float g = c[1][e]; const float sg = g * __builtin_amdgcn_rcpf(1.f + __builtin_amdgcn_exp2f(-1.4426950408889634f * g)); o[e] = c[0][e] * sg; }
                    u32x2 pk; pk.x = cvt_pk_bf16(o[0], o[1]); pk.y = cvt_pk_bf16(o[2], o[3]);
                    if (n == 0) keep[ai][m] = pk;
                    else { u32x4 w4; w4.x = keep[ai][m].x; w4.y = keep[ai][m].y; w4.z = pk.x; w4.w = pk.y; *(u32x4*)(act + (size_t)(rowb + ai * HALF + m * 16) * 2816 + fcol) = w4; }
                    asm volatile("" ::: "memory");
                }
            }
        }
    }
};
template <class Epi, class Sched, bool ALIGN_EPI = false, bool SP2 = false>
__device__ __forceinline__ void gemm_phase(PG8_LAS unsigned char* lds, const Gemm g, const Sched& S, const Epi& E) {
    const int tid = threadIdx.x, wid = __builtin_amdgcn_readfirstlane(tid >> 6), lane = tid & 63, wr = wid >> 2, wc = wid & 3, fr = lane & 15, fq = lane >> 4;
    const int K = g.K, nt = K / BK;
    unsigned voffA[2], voffB[2];
#pragma unroll
    for (int i = 0; i < 2; ++i) { int R, C; stage_rc(tid * 16 + i * 8192, R, C); const int Rb = Epi::PERM ? ((R & ~31) + perm32(R & 31)) : R;
        voffA[i] = (unsigned)(R * K + C) * 2u; voffB[i] = (unsigned)(Rb * K + C) * 2u; }
    const size_t kstep = (size_t)(BK * 2);
    const size_t hstep = (size_t)HALF * K * 2;
    const size_t tstep = 2 * hstep;
    const unsigned ldsw = (unsigned)wid * 1024u;
    const int aoff = lds_byte(wr * 64 + fr, fq * 8), boff = lds_byte(wc * 32 + fr, fq * 8);
#define PG8_SA(b, h) (((b) * 2 + (h)) * HTB)
#define PG8_SB(b, h) ((4 + (b) * 2 + (h)) * HTB)
#define PG8_STAGE(bufoff, gbase, voff) do { _Pragma("unroll") for (int _i = 0; _i < 2; ++_i) \
        __builtin_amdgcn_global_load_lds((const unsigned*)((const char*)(gbase) + (voff)[_i]), (PG8_LAS unsigned*)(lds + (bufoff) + ldsw + _i * 8192), 16, 0, 0); } while (0)
#define PG8_LDA(dst, b, h) do { _Pragma("unroll") for (int m = 0; m < 4; ++m) _Pragma("unroll") for (int k = 0; k < 2; ++k) dst[m][k] = *(const PG8_LAS bf16x8*)(lds + PG8_SA(b, h) + aoff + m * 2048 + k * 1024); } while (0)
#define PG8_LDB(dst, b, h) do { _Pragma("unroll") for (int n = 0; n < 2; ++n) _Pragma("unroll") for (int k = 0; k < 2; ++k) dst[n][k] = *(const PG8_LAS bf16x8*)(lds + PG8_SB(b, h) + boff + n * 2048 + k * 1024); } while (0)
#define PG8_MMA(ai, bj, At, Bt) do { __builtin_amdgcn_s_setprio(1); _Pragma("unroll") for (int m = 0; m < 4; ++m) _Pragma("unroll") for (int n = 0; n < 2; ++n) _Pragma("unroll") for (int k = 0; k < 2; ++k) \
        acc[ai][bj][m][n] = __builtin_amdgcn_mfma_f32_16x16x32_bf16(Bt[n][k], At[m][k], acc[ai][bj][m][n], 0, 0, 0); __builtin_amdgcn_s_setprio(0); } while (0)
#define PG8_WAIT_V(n) asm volatile("s_waitcnt vmcnt(" #n ")" ::: "memory")
#define PG8_WAIT_L(n) asm volatile("s_waitcnt lgkmcnt(" #n ")" ::: "memory")
#define PG8_BAR __builtin_amdgcn_s_barrier()
#define PG8_SCHED __builtin_amdgcn_sched_barrier(0)
    Unit cur, nxt; int ui = 0;
    if (!S.next(0, cur)) return;
    f32x4 acc[2][2][4][2];
#pragma unroll
    for (int a = 0; a < 2; ++a)
#pragma unroll
        for (int b = 0; b < 2; ++b)
#pragma unroll
            for (int m = 0; m < 4; ++m)
#pragma unroll
                for (int n = 0; n < 2; ++n) acc[a][b][m][n] = (f32x4){0.f, 0.f, 0.f, 0.f};
    bf16x8 At[4][2], B0[2][2], B1[2][2];
    const char* cA = (const char*)g.A + (size_t)cur.pm * tstep; const char* cB = (const char*)g.Bt + (size_t)cur.pn * tstep;
    S.a_ready(cur);
    if constexpr (SP2) {
        PG8_STAGE(PG8_SB(0, 0), cB, voffB); PG8_STAGE(PG8_SB(0, 1), cB + hstep, voffB); PG8_STAGE(PG8_SA(0, 0), cA, voffA); PG8_STAGE(PG8_SA(0, 1), cA + hstep, voffA);
        if (wr == 1) PG8_BAR;
        PG8_WAIT_V(2); PG8_BAR;
        PG8_STAGE(PG8_SB(1, 0), cB + kstep, voffB); PG8_STAGE(PG8_SA(1, 0), cA + kstep, voffA); PG8_STAGE(PG8_SB(1, 1), cB + hstep + kstep, voffB);
        PG8_WAIT_V(6); PG8_BAR;
    } else {
        PG8_STAGE(PG8_SB(0, 0), cB, voffB); PG8_STAGE(PG8_SA(0, 0), cA, voffA); PG8_STAGE(PG8_SB(0, 1), cB + hstep, voffB); PG8_STAGE(PG8_SA(0, 1), cA + hstep, voffA);
        if (wr == 1) PG8_BAR;
        PG8_WAIT_V(4); PG8_BAR;
        PG8_STAGE(PG8_SB(1, 0), cB + kstep, voffB); PG8_STAGE(PG8_SA(1, 0), cA + kstep, voffA); PG8_STAGE(PG8_SB(1, 1), cB + hstep + kstep, voffB);
        PG8_WAIT_V(6); PG8_BAR;
    }
    for (;;) {
        const bool has_next = S.next(ui + 1, nxt);
        const char* nA = has_next ? (const char*)g.A + (size_t)nxt.pm * tstep : cA; const char* nB = has_next ? (const char*)g.Bt + (size_t)nxt.pn * tstep : cB;
        for (int t = 0; t < nt; t += 2) {
            const bool last = (t == nt - 2);
            const char* a1 = cA + (size_t)(t + 1) * kstep;
            const char* a2 = last ? nA : cA + (size_t)(t + 2) * kstep; const char* b2 = last ? nB : cB + (size_t)(t + 2) * kstep;
            const char* a3 = a2 + kstep; const char* b3 = b2 + kstep;
            if (last && has_next) S.a_ready(nxt);
            if constexpr (SP2) {
            PG8_LDB(B0, 0, 0); PG8_LDB(B1, 0, 1); PG8_SCHED; PG8_LDA(At, 0, 0); PG8_STAGE(PG8_SA(1, 1), a1 + hstep, voffA);
            PG8_WAIT_V(8); PG8_WAIT_L(0); PG8_BAR; PG8_MMA(0, 0, At, B0); PG8_MMA(0, 1, At, B1); PG8_BAR; PG8_SCHED;
            PG8_LDA(At, 0, 1); PG8_STAGE(PG8_SB(0, 0), b2, voffB); PG8_STAGE(PG8_SB(0, 1), b2 + hstep, voffB); PG8_STAGE(PG8_SA(0, 0), a2, voffA);
            PG8_WAIT_V(8); PG8_WAIT_L(0); PG8_BAR; PG8_MMA(1, 0, At, B0); PG8_MMA(1, 1, At, B1); PG8_BAR; PG8_SCHED;
            PG8_LDB(B0, 1, 0); PG8_LDB(B1, 1, 1); PG8_SCHED; PG8_LDA(At, 1, 0); PG8_STAGE(PG8_SA(0, 1), a2 + hstep, voffA);
            PG8_WAIT_V(8); PG8_WAIT_L(0); PG8_BAR; PG8_MMA(0, 0, At, B0); PG8_MMA(0, 1, At, B1); PG8_BAR; PG8_SCHED;
            PG8_LDA(At, 1, 1); PG8_STAGE(PG8_SB(1, 0), b3, voffB); PG8_STAGE(PG8_SB(1, 1), b3 + hstep, voffB); PG8_STAGE(PG8_SA(1, 0), a3, voffA);
            PG8_WAIT_V(8); PG8_WAIT_L(0); PG8_BAR; PG8_MMA(1, 0, At, B0); PG8_MMA(1, 1, At, B1); PG8_BAR; PG8_SCHED;
            } else {
            PG8_LDB(B0, 0, 0); PG8_SCHED; PG8_LDA(At, 0, 0); PG8_STAGE(PG8_SA(1, 1), a1 + hstep, voffA);
            PG8_WAIT_L(8); PG8_BAR; PG8_WAIT_L(0); PG8_MMA(0, 0, At, B0); PG8_BAR; PG8_SCHED;
            PG8_LDB(B1, 0, 1); PG8_STAGE(PG8_SB(0, 0), b2, voffB);
            PG8_BAR; PG8_WAIT_L(0); PG8_MMA(0, 1, At, B1); PG8_BAR;
            PG8_LDA(At, 0, 1); PG8_STAGE(PG8_SA(0, 0), a2, voffA);
            PG8_BAR; PG8_WAIT_L(0); PG8_MMA(1, 0, At, B0); PG8_BAR; PG8_SCHED;
            PG8_STAGE(PG8_SB(0, 1), b2 + hstep, voffB);
            PG8_WAIT_V(6); PG8_BAR; PG8_MMA(1, 1, At, B1); PG8_BAR;
            PG8_LDB(B0, 1, 0); PG8_SCHED; PG8_LDA(At, 1, 0); PG8_STAGE(PG8_SA(0, 1), a2 + hstep, voffA);
            PG8_WAIT_L(8); PG8_BAR; PG8_WAIT_L(0); PG8_MMA(0, 0, At, B0); PG8_BAR; PG8_SCHED;
            PG8_LDB(B1, 1, 1); PG8_STAGE(PG8_SB(1, 0), b3, voffB);
            PG8_BAR; PG8_WAIT_L(0); PG8_MMA(0, 1, At, B1); PG8_BAR;
            PG8_LDA(At, 1, 1); PG8_STAGE(PG8_SA(1, 0), a3, voffA);
            PG8_BAR; PG8_WAIT_L(0); PG8_MMA(1, 0, At, B0); PG8_BAR; PG8_SCHED;
            PG8_STAGE(PG8_SB(1, 1), b3 + hstep, voffB);
            PG8_WAIT_V(6); PG8_BAR; PG8_MMA(1, 1, At, B1); PG8_BAR;
            }
        }
        if constexpr (ALIGN_EPI) { if (wr == 0) PG8_BAR; }
        if constexpr (!Epi::AFTER_DRAIN) { E(acc, cur, wr, wc, fr, fq); S.done(cur); }
        if (!has_next) break;
#pragma unroll
        for (int a = 0; a < 2; ++a)
#pragma unroll
            for (int b = 0; b < 2; ++b)
#pragma unroll
                for (int m = 0; m < 4; ++m)
#pragma unroll
                    for (int n = 0; n < 2; ++n) acc[a][b][m][n] = (f32x4){0.f, 0.f, 0.f, 0.f};
        cur = nxt; cA = nA; cB = nB; ++ui;
        if constexpr (ALIGN_EPI) { if (wr == 1) PG8_BAR; }
    }
    PG8_WAIT_V(0);
    if constexpr (!ALIGN_EPI) { if (wr == 0) PG8_BAR; }
    PG8_BAR;
    if constexpr (Epi::AFTER_DRAIN) { E.fused(acc, cur, wr, wc, fr, fq, lds, wid, lane); S.done(cur); }
#undef PG8_SA
#undef PG8_SB
#undef PG8_STAGE
#undef PG8_LDA
#undef PG8_LDB
#undef PG8_MMA
#undef PG8_WAIT_V
#undef PG8_WAIT_L
#undef PG8_BAR
#undef PG8_SCHED
}
}
#define LAS __attribute__((address_space(3)))
typedef unsigned short bf16;
typedef short bf16x8 __attribute__((ext_vector_type(8)));
typedef float f32x4 __attribute__((ext_vector_type(4)));
typedef float f32x16 __attribute__((ext_vector_type(16)));
typedef unsigned u32x4 __attribute__((ext_vector_type(4)));
typedef unsigned u32x2 __attribute__((ext_vector_type(2)));
constexpr int NB = 32, SEQ = 2048, D = 1024, MTOK = NB * SEQ, MEML = 256, MMEM = NB * MEML, DFF = 2816, NUP = 2 * DFF, NPROJ = 2560;
constexpr float LOG2E = 1.4426950408889634f, QS = 0.125f * LOG2E;
constexpr size_t MiB = 1u << 20;
constexpr size_t WS_W1 = 0 * MiB, WS_W3 = 5 * MiB, WS_WM = 7 * MiB, WS_W4 = 9 * MiB, WS_W5 = 20 * MiB, WS_W6 = 26 * MiB, WS_W8 = 31 * MiB, WS_W9 = 33 * MiB, WS_W10 = 44 * MiB;
constexpr size_t WS_CWP = 50 * MiB, WS_SSPX = 51 * MiB, WS_SSP1 = 55 * MiB, WS_SSP2 = 59 * MiB, WS_SSP3 = 63 * MiB, WS_SSP4 = 67 * MiB, WS_SSPM = 71 * MiB;
constexpr size_t WS_LSE = 72 * MiB, WS_SIDE = 76 * MiB, WS_MEMB = 98 * MiB, WS_MEMKV = 114 * MiB, WS_HB = 130 * MiB, WS_PROJ = 258 * MiB, WS_ATT = 578 * MiB, WS_ACT = 258 * MiB, WS_CTL = 706 * MiB, CTL_BYTES = 16384, WS_END = 707 * MiB;
constexpr int NWAVES = 8, NTHREADS = 512;
constexpr int LDS_X_OFF = 131072, LDS_MISC_OFF = 131072 + 8192, LDS_BYTES = 147456;

__device__ __forceinline__ unsigned cvtpk(float lo, float hi) { unsigned r; asm volatile("v_cvt_pk_bf16_f32 %0, %1, %2" : "=v"(r) : "v"(lo), "v"(hi)); return r; }
__device__ __forceinline__ float wave_sum(float v) {
#pragma unroll
    for (int o = 1; o < 64; o <<= 1) v += __shfl_xor(v, o);
    return v;
}
__device__ __forceinline__ float ex2(float x) { return __builtin_amdgcn_exp2f(x); }
__device__ __forceinline__ float lg2(float x) { return __builtin_amdgcn_logf(x); }

namespace att {
constexpr int KT_BYTES = 64 * 144, VT_BYTES = 64 * 144, HEAD_BYTES = KT_BYTES + VT_BYTES, FLAG_OFF = 2 * HEAD_BYTES;
struct TileRegs { u32x4 k[2], v[2]; };
template <int NH> __device__ __forceinline__ void tile_load(TileRegs& t, const bf16* K, const bf16* V, int pitch, long tok0, int tstride, int tid) {
#pragma unroll
    for (int i = 0; i < NH; ++i) { const int cid = tid + NTHREADS * i, key = cid / (8 * NH), cc = cid % (8 * NH);
        const size_t off = (size_t)(tok0 + (long)key * tstride) * pitch + cc * 8;
        t.k[i] = *(const u32x4*)(K + off); t.v[i] = *(const u32x4*)(V + off); }
}
template <int NH> __device__ __forceinline__ void tile_store(const TileRegs& t, LAS unsigned char* lds, int tid) {
#pragma unroll
    for (int i = 0; i < NH; ++i) { const int cid = tid + NTHREADS * i, key = cid / (8 * NH), cc = cid % (8 * NH), h2 = cc / 8, c8 = cc % 8;
        *(LAS u32x4*)(lds + h2 * HEAD_BYTES + key * 144 + c8 * 16) = t.k[i];
        *(LAS u32x4*)(lds + h2 * HEAD_BYTES + KT_BYTES + key * 144 + c8 * 16) = t.v[i]; }
}
struct UDesc { const bf16* q; const bf16* K; const bf16* V; int pitch; long tok0; int tstride; int nh; };
__device__ __forceinline__ void unit_prefetch(TileRegs& t, bf16x8 (&qf)[4], const UDesc& d, int tid) {
    if (d.q) { const int hi = (tid >> 5) & 1;
        if (d.nh == 2) tile_load<2>(t, d.K, d.V, d.pitch, d.tok0, d.tstride, tid); else tile_load<1>(t, d.K, d.V, d.pitch, d.tok0, d.tstride, tid);
#pragma unroll
        for (int d0 = 0; d0 < 4; ++d0) qf[d0] = *(const bf16x8*)(d.q + d0 * 16 + hi * 8); }
}
template <bool BIAS = false> __device__ __forceinline__ void st_tile(f32x16 (&p)[2], const LAS unsigned char* kt, const bf16x8 (&qf)[4], int r32, int hi, float binit0 = 0.f, float bslope = 0.f) {
#pragma unroll
    for (int kh = 0; kh < 2; ++kh) { f32x16 a = {};
        if (BIAS) {
#pragma unroll
            for (int r = 0; r < 16; ++r) a[r] = __builtin_fmaf(bslope, (float)(32 * kh + 8 * (r >> 2) + (r & 3)), binit0); }
#pragma unroll
        for (int d0 = 0; d0 < 4; ++d0) { const bf16x8 kf = *(const LAS bf16x8*)(kt + (kh * 32 + r32) * 144 + d0 * 32 + hi * 16); a = __builtin_amdgcn_mfma_f32_32x32x16_bf16(kf, qf[d0], a, 0, 0, 0); }
        p[kh] = a; }
}
typedef short v4i16_t __attribute__((ext_vector_type(4)));
__device__ __forceinline__ v4i16_t vtr(const LAS unsigned char* p) { return __builtin_amdgcn_ds_read_tr16_b64_v4i16((LAS v4i16_t*)p); }
__device__ __forceinline__ void pv_tile(f32x16 (&o)[2], const LAS unsigned char* vt, const f32x16 (&p)[2], int lane) {
    const int l16 = lane & 15, g1 = (lane >> 4) & 1, hi = lane >> 5;
    const LAS unsigned char* vl = vt + (4 * hi + (l16 >> 2)) * 144 + (16 * g1 + 4 * (l16 & 3)) * 2;
#pragma unroll
    for (int kh = 0; kh < 2; ++kh)
#pragma unroll
        for (int a = 0; a < 2; ++a) { u32x4 pw; pw.x = cvtpk(p[kh][8 * a + 0], p[kh][8 * a + 1]); pw.y = cvtpk(p[kh][8 * a + 2], p[kh][8 * a + 3]); pw.z = cvtpk(p[kh][8 * a + 4], p[kh][8 * a + 5]); pw.w = cvtpk(p[kh][8 * a + 6], p[kh][8 * a + 7]);
            const bf16x8 pb = __builtin_bit_cast(bf16x8, pw);
#pragma unroll
            for (int dh = 0; dh < 2; ++dh) { const LAS unsigned char* vp = vl + (kh * 32 + 16 * a) * 144 + dh * 64;
                const v4i16_t lo = vtr(vp), hi4 = vtr(vp + 8 * 144);
                const bf16x8 va = (bf16x8){lo[0], lo[1], lo[2], lo[3], hi4[0], hi4[1], hi4[2], hi4[3]};
                o[dh] = __builtin_amdgcn_mfma_f32_32x32x16_bf16(va, pb, o[dh], 0, 0, 0); } }
}
__device__ __forceinline__ void store_o(bf16* op, const f32x16 (&o)[2], float sc, int hi) {
#pragma unroll
    for (int dh = 0; dh < 2; ++dh)
#pragma unroll
        for (int c = 0; c < 4; ++c) { u32x2 w; w.x = cvtpk(o[dh][4 * c] * sc, o[dh][4 * c + 1] * sc); w.y = cvtpk(o[dh][4 * c + 2] * sc, o[dh][4 * c + 3] * sc);
            *(u32x2*)(op + dh * 32 + 8 * c + 4 * hi) = w; }
}

constexpr float SB_DONE = 151.0f;
__device__ __forceinline__ void sb_unit(LAS unsigned char* lds, TileRegs& tr, bf16x8 (&qf)[4], const UDesc& nxt, const bf16* PROJ, bf16* ATT, int b, int h, int qb, int tid) {
    const int lane = tid & 63, r32 = lane & 31, hi = lane >> 5, wid = __builtin_amdgcn_readfirstlane(tid >> 6);
    const long tokb = (long)b * SEQ; const int tq = qb * 256 + wid * 32 + r32;
    const bf16* Kb = PROJ + 768 + h * 64; const bf16* Vb = PROJ + 1536 + h * 64;
    f32x16 o[2]; o[0] = f32x16{}; o[1] = f32x16{};
    float carry = 0.f;
    const int kt_last = qb * 4 + 3, tq_min = qb * 256 + wid * 32, tq_max = tq_min + 31;
    TileRegs nx; bf16x8 qn[4];
    volatile LAS int* flags = (volatile LAS int*)(lds + FLAG_OFF);
    bool done = false;
    for (int kt = kt_last; kt >= 0; --kt) {
        __syncthreads();
        if (kt != kt_last) { int any = 0;
#pragma unroll
            for (int w = 0; w < 8; ++w) any |= flags[w];
            if (!any) break; }
        tile_store<1>(tr, lds, tid);
        if (kt > 0) tile_load<1>(tr, Kb, Vb, NPROJ, tokb + (kt - 1) * 64, 1, tid);
        if (kt == kt_last) unit_prefetch(nx, qn, nxt, tid);
        __syncthreads();
        const int k0 = kt * 64;
        if (!done && k0 < tq_max) {
            f32x16 p[2]; st_tile(p, lds, qf, r32, hi);
            if (k0 + 63 >= tq_min) {
#pragma unroll
                for (int kh = 0; kh < 2; ++kh)
#pragma unroll
                    for (int r = 0; r < 16; ++r) { const int kpos = k0 + kh * 32 + 8 * (r >> 2) + 4 * hi + (r & 3); if (kpos >= tq) p[kh][r] = -1e30f; }
            }
            f32x16 l[2]; float gs[8];
#pragma unroll
            for (int kh = 0; kh < 2; ++kh) {
#pragma unroll
                for (int r = 0; r < 16; ++r) { float z; asm("v_min_f32 %0, %1, %2" : "=v"(z) : "v"(p[kh][r]), "v"(100.f)); p[kh][r] = z; l[kh][r] = lg2(1.f + ex2(z)); }
#pragma unroll
                for (int c = 0; c < 4; ++c) gs[kh * 4 + c] = (l[kh][4 * c] + l[kh][4 * c + 1]) + (l[kh][4 * c + 2] + l[kh][4 * c + 3]);
            }
            float pg[8], T[8], E[8];
#pragma unroll
            for (int j = 0; j < 8; ++j) { pg[j] = __shfl_xor(gs[j], 32); T[j] = gs[j] + pg[j]; }
            float st = 0.f;
#pragma unroll
            for (int j = 7; j >= 0; --j) { E[j] = carry + st + (hi == 0 ? pg[j] : 0.f); st += T[j]; }
            carry += st;
#pragma unroll
            for (int kh = 0; kh < 2; ++kh)
#pragma unroll
                for (int c = 0; c < 4; ++c) { float lat = E[kh * 4 + c];
#pragma unroll
                    for (int i = 3; i >= 0; --i) { const int r = 4 * c + i; lat += l[kh][r]; p[kh][r] = ex2(p[kh][r] - lat); } }
            pv_tile(o, lds + KT_BYTES, p, lane);
            done = __all(carry > SB_DONE);
        }
        if (lane == 0) flags[wid] = done ? 0 : 1;
    }
    store_o(ATT + (size_t)(tokb + tq) * D + h * 64, o, 1.f, hi);
    if (nxt.q) { tr = nx;
#pragma unroll
        for (int d0 = 0; d0 < 4; ++d0) qf[d0] = qn[d0]; }
}

template <int NH, bool MASKED>
__device__ __forceinline__ void sm_unit(LAS unsigned char* lds, TileRegs& tr, bf16x8 (&qf)[4], const UDesc& nxt, const bf16* K, const bf16* V, int kvpitch, long ktok0, int kstride,
                                        int jt0, int irow, float slope2d, bf16* orow, float* lserow, int tid) {
    const int lane = tid & 63, r32 = lane & 31, hi = lane >> 5, wid = __builtin_amdgcn_readfirstlane(tid >> 6);
    const int h2 = (NH == 2) ? (wid >> 2) : 0, i0 = (NH == 2) ? (wid & 3) * 32 : wid * 32;
    f32x16 o[2]; o[0] = f32x16{}; o[1] = f32x16{};
    float m = -1e30f, lsum = 0.f;
    TileRegs nx; bf16x8 qn[4];
    for (int jt = jt0; jt < 4; ++jt) {
        __syncthreads();
        tile_store<NH>(tr, lds, tid);
        if (jt < 3) tile_load<NH>(tr, K, V, kvpitch, ktok0 + (long)(jt + 1) * 64 * kstride, kstride, tid);
        if (jt == jt0) unit_prefetch(nx, qn, nxt, tid);
        __syncthreads();
        const int j0 = jt * 64;
        const bool active = !MASKED || ((j0 + 63 >= i0) && (j0 <= i0 + 159));
        if (active) {
            f32x16 p[2];
            st_tile<MASKED>(p, lds + h2 * HEAD_BYTES, qf, r32, hi, slope2d * (float)(j0 + 4 * hi), slope2d);
            if (MASKED && !((j0 >= i0 + 31) && (j0 + 63 <= i0 + 128))) {
                const int jb = j0 + 4 * hi - irow;
#pragma unroll
                for (int kh = 0; kh < 2; ++kh)
#pragma unroll
                    for (int r = 0; r < 16; ++r) { const int dj = jb + kh * 32 + 8 * (r >> 2) + (r & 3); if ((unsigned)dj > 128u) p[kh][r] = -1e30f; }
            }
            float tm = p[0][0];
#pragma unroll
            for (int kh = 0; kh < 2; ++kh)
#pragma unroll
                for (int r = 0; r < 16; ++r) tm = __builtin_fmaxf(tm, p[kh][r]);
            tm = __builtin_fmaxf(tm, __shfl_xor(tm, 32));
            const float mn = __builtin_fmaxf(m, tm), al = ex2(m - mn); m = mn;
            float s = 0.f;
#pragma unroll
            for (int kh = 0; kh < 2; ++kh)
#pragma unroll
                for (int r = 0; r < 16; ++r) { const float e = ex2(p[kh][r] - mn); p[kh][r] = e; s += e; }
            lsum = lsum * al + s;
#pragma unroll
            for (int dh = 0; dh < 2; ++dh)
#pragma unroll
                for (int r = 0; r < 16; ++r) o[dh][r] *= al;
            pv_tile(o, lds + h2 * HEAD_BYTES + KT_BYTES, p, lane);
        }
    }
    const float lt = lsum + __shfl_xor(lsum, 32);
    store_o(orow, o, __builtin_amdgcn_rcpf(lt), hi);
    if (lserow && hi == 0) *lserow = m + lg2(lt) - slope2d * (float)(irow + 128);
    if (nxt.q) { tr = nx;
#pragma unroll
        for (int d0 = 0; d0 < 4; ++d0) qf[d0] = qn[d0]; }
}
}
#define XB_TMO      128
#define XB_XCNT(j)  (256  + 64 * (j))
#define XB_XSUB(j)  (1280 + 64 * (j))
#define XB_XGEN(j)  (2304 + 64 * (j))
#define XB_TOP      3328
#define XB_TOPGEN   3392
#define XCD_BAR_WORDS 3456
#define XB_SPIN_CAP (1u << 18)

__device__ __forceinline__ unsigned xb_ld(unsigned* p)              { return __hip_atomic_load(p, __ATOMIC_RELAXED, __HIP_MEMORY_SCOPE_AGENT); }
__device__ __forceinline__ unsigned xb_add(unsigned* p, unsigned v) { return __hip_atomic_fetch_add(p, v, __ATOMIC_RELAXED, __HIP_MEMORY_SCOPE_AGENT); }
__device__ __forceinline__ unsigned xb_xcc_id() { return (unsigned)__builtin_amdgcn_s_getreg((3 << 11) | 20) & 0xFu; }
#define XB_SPIN(cond, bar) do { unsigned _sp = 0; while (cond) { __builtin_amdgcn_s_sleep(1); \
    if ((++_sp & 255u) == 0u) { if (xb_ld(&(bar)[XB_TMO])) break; if (_sp > XB_SPIN_CAP) { atomicAdd(&(bar)[XB_TMO], 1u); break; } } } } while (0)

struct XcdBarrier {
    unsigned* bar; unsigned x;
    volatile LAS unsigned* st;
};

__device__ __forceinline__ XcdBarrier xcd_barrier_post(unsigned* bar, volatile LAS unsigned* st) {
    XcdBarrier b; b.bar = bar; b.x = xb_xcc_id(); b.st = st;
    if (threadIdx.x == 0) (void)xb_add(&bar[XB_XCNT(b.x)], 1u);
    return b;
}
__device__ __forceinline__ void xcd_barrier_complete(unsigned* bar, unsigned x, unsigned& nloc, unsigned& nx) {
    const unsigned G = gridDim.x * gridDim.y * gridDim.z;
    unsigned sum, cnt, mine, sp = 0u;
    for (;;) {
        sum = 0u; cnt = 0u; mine = 0u;
#pragma unroll
        for (unsigned j = 0; j < 16; ++j) { const unsigned c = xb_ld(&bar[XB_XCNT(j)]); sum += c; cnt += (c > 0u) ? 1u : 0u; mine = (j == x) ? c : mine; }
        if (sum == G) break;
        __builtin_amdgcn_s_sleep(1);
        if ((++sp & 255u) == 0u) { if (xb_ld(&bar[XB_TMO])) break; if (sp > XB_SPIN_CAP) { atomicAdd(&bar[XB_TMO], 1u); break; } }
    }
    nloc = mine > 0u ? mine : 1u; nx = cnt > 0u ? cnt : 1u;
}

__device__ __forceinline__ void xcd_barrier(const XcdBarrier& b) {
    asm volatile("s_waitcnt vmcnt(0)" ::: "memory");
    __syncthreads();
    if (threadIdx.x == 0) {
        unsigned* bar = b.bar;
        __builtin_amdgcn_s_waitcnt(0);
        unsigned nloc = b.st[0], nx = b.st[1];
        if (nloc == 0u) { xcd_barrier_complete(bar, b.x, nloc, nx); b.st[0] = nloc; b.st[1] = nx; }
        const unsigned old = xb_add(&bar[XB_XSUB(b.x)], 1u);
        const unsigned gen = old / nloc;
        if (old + 1u == (gen + 1u) * nloc) {
            __builtin_amdgcn_fence(__ATOMIC_RELEASE, "agent");
            asm volatile("s_waitcnt vmcnt(0)" ::: "memory");
            const unsigned og = xb_add(&bar[XB_TOP], 1u);
            const unsigned tg = og / nx;
            if (og + 1u == (tg + 1u) * nx) xb_add(&bar[XB_TOPGEN], 1u);
            else XB_SPIN(xb_ld(&bar[XB_TOPGEN]) == tg, bar);
            __builtin_amdgcn_fence(__ATOMIC_ACQUIRE, "agent");
            xb_add(&bar[XB_XGEN(b.x)], 1u);
            asm volatile("s_waitcnt vmcnt(0)" ::: "memory");
        } else {
            XB_SPIN(xb_ld(&bar[XB_XGEN(b.x)]) == gen, bar);
            __builtin_amdgcn_fence(__ATOMIC_ACQUIRE, "agent");
            asm volatile("s_waitcnt vmcnt(0)" ::: "memory");
        }
    }
    __syncthreads();
}

#ifndef PROBE_FLAGS
#define PROBE_FLAGS 0
#endif
#ifndef REP_MASK
#define REP_MASK 0
#endif
#ifndef MK_ONE_LAUNCH
#define MK_ONE_LAUNCH 1
#endif
constexpr int N_PHASES = 15;
struct Args { const void* in[23]; float* out; unsigned char* ws; int ph_lo, ph_hi, flags, pad; };
static_assert(sizeof(Args) == 23 * 8 + 8 + 8 + 16, "Args has no padding");

__device__ __forceinline__ void transpose_item(const float* W, int K, int N, bf16* WT, int k0, int n0, int drow0, const float* gain, float cscale, LAS float* scr, int lane) {
#pragma unroll 8
    for (int i = 0; i < 32; ++i) { const int kk = 2 * i + (lane >> 5); const float g = gain ? gain[k0 + kk] * cscale : cscale; scr[kk * 33 + (lane & 31)] = W[(size_t)(k0 + kk) * N + n0 + (lane & 31)] * g; }
    asm volatile("s_waitcnt lgkmcnt(0)" ::: "memory");
    const int c = lane & 7;
#pragma unroll
    for (int j = 0; j < 4; ++j) { const int n = (lane >> 3) + 8 * j; const LAS float* s = scr + (8 * c) * 33 + n;
        u32x4 o; o.x = cvtpk(s[0 * 33], s[1 * 33]); o.y = cvtpk(s[2 * 33], s[3 * 33]); o.z = cvtpk(s[4 * 33], s[5 * 33]); o.w = cvtpk(s[6 * 33], s[7 * 33]);
        *(u32x4*)(WT + (size_t)(drow0 + n) * K + k0 + 8 * c) = o; }
    asm volatile("s_waitcnt lgkmcnt(0)" ::: "memory");
}
template <int NR> __device__ __forceinline__ void row_prep(const float* xrow, bf16* orow, float* ssp, int lane) {
    f32x4 v[NR][4]; float s[NR];
#pragma unroll
    for (int r = 0; r < NR; ++r)
#pragma unroll
        for (int j = 0; j < 4; ++j) v[r][j] = __builtin_nontemporal_load((const f32x4*)(xrow + (size_t)r * D) + lane + 64 * j);
#pragma unroll
    for (int r = 0; r < NR; ++r) { s[r] = 0.f;
#pragma unroll
        for (int j = 0; j < 4; ++j) s[r] += (v[r][j][0] * v[r][j][0] + v[r][j][1] * v[r][j][1]) + (v[r][j][2] * v[r][j][2] + v[r][j][3] * v[r][j][3]);
        s[r] = wave_sum(s[r]);
        u32x2* o8 = (u32x2*)(orow + (size_t)r * D) + lane;
#pragma unroll
        for (int j = 0; j < 4; ++j) { u32x2 w; w.x = cvtpk(v[r][j][0], v[r][j][1]); w.y = cvtpk(v[r][j][2], v[r][j][3]); o8[64 * j] = w; }
        if (lane < 16) ssp[r * 16 + lane] = (lane == 0) ? s[r] : 0.f; }
}

__global__ void __launch_bounds__(NTHREADS, 2) yoco_fwd(Args args) {
    extern __shared__ __attribute__((aligned(16))) unsigned char lds_raw[];
    LAS unsigned char* lds = (LAS unsigned char*)lds_raw;
    const int tid = threadIdx.x, lane = tid & 63, wave = __builtin_amdgcn_readfirstlane(tid >> 6);
    const int G = gridDim.x, bx = blockIdx.x;
    const int gw = bx * NWAVES + wave, NGW = G * NWAVES;
    unsigned char* ws = args.ws;
    const float* x = (const float*)args.in[0]; const float* mem = (const float*)args.in[1];
    float* out = args.out;
    bf16* W1 = (bf16*)(ws + WS_W1); bf16* W3 = (bf16*)(ws + WS_W3); bf16* WM = (bf16*)(ws + WS_WM); bf16* W4 = (bf16*)(ws + WS_W4); bf16* W5 = (bf16*)(ws + WS_W5);
    bf16* W6 = (bf16*)(ws + WS_W6); bf16* W8 = (bf16*)(ws + WS_W8); bf16* W9 = (bf16*)(ws + WS_W9); bf16* W10 = (bf16*)(ws + WS_W10);
    float* CWP = (float*)(ws + WS_CWP);
    float* SSPX = (float*)(ws + WS_SSPX); float* SSP1 = (float*)(ws + WS_SSP1); float* SSP2 = (float*)(ws + WS_SSP2); float* SSP3 = (float*)(ws + WS_SSP3); float* SSP4 = (float*)(ws + WS_SSP4); float* SSPM = (float*)(ws + WS_SSPM);
    float* LSE = (float*)(ws + WS_LSE); float* SIDE = (float*)(ws + WS_SIDE);
    bf16* MEMB = (bf16*)(ws + WS_MEMB); bf16* MEMKV = (bf16*)(ws + WS_MEMKV); bf16* HB = (bf16*)(ws + WS_HB); bf16* PROJ = (bf16*)(ws + WS_PROJ); bf16* ATT = (bf16*)(ws + WS_ATT); bf16* ACT = (bf16*)(ws + WS_ACT);
    const int lo = args.ph_lo, hi_ph = args.ph_hi;
    XcdBarrier xbar; xbar.bar = (unsigned*)(ws + WS_CTL); xbar.x = 0; xbar.st = nullptr;
    if (hi_ph - lo > 1) {
        volatile LAS unsigned* st = (volatile LAS unsigned*)(lds + LDS_MISC_OFF); if (tid < 2) st[tid] = 0u; __syncthreads();
        xbar = xcd_barrier_post((unsigned*)(ws + WS_CTL), st); }
    if (args.flags < 0) cg::this_grid().sync();
#define IN(k) (lo <= (k) && (k) < hi_ph)
#define SEAM(k) do { if (IN(k) && IN((k) + 1)) { xcd_barrier(xbar); } } while (0)

    if (IN(0)) {
        LAS float* scr = (LAS float*)(lds + wave * 16384);
        int base = 0;
#define DO_W(SRC, KK, NN, GAIN, KIND, DST, ROFF) do { constexpr int nblk = (NN) / 32, cnt = ((KK) / 64) * nblk; \
            const float* W = (const float*)args.in[SRC]; const float* gain = (GAIN) >= 0 ? (const float*)args.in[(GAIN) >= 0 ? (GAIN) : 0] : nullptr; bf16* WT = (bf16*)(ws + (DST)); \
            const int first = (gw - base % NGW + NGW) % NGW; \
            for (int r = first; r < cnt; r += NGW) { const int kb = r / nblk, nb = r % nblk, k0 = 64 * kb, n0 = 32 * nb; float cs = 1.f; int drow0 = (ROFF) + n0; \
                if ((KIND) == 1) cs = (n0 < 768 || n0 >= 2304) ? QS : 1.f; else if ((KIND) == 2) cs = QS; \
                else if ((KIND) == 3) { const int half = n0 / DFF, j = n0 % DFF; drow0 = 256 * (j / 128) + 128 * half + (j % 128); } \
                transpose_item(W, (KK), (NN), WT, k0, n0, drow0, gain, cs, scr, lane); } \
            base += cnt; } while (0)
        DO_W(3, D, NPROJ, 2, 1, WS_W1, 0); DO_W(4, D, D, -1, 0, WS_W3, 0); DO_W(6, D, 512, 5, 0, WS_WM, 0); DO_W(17, D, 512, 16, 0, WS_WM, 512);
        DO_W(8, D, NUP, 7, 3, WS_W4, 0); DO_W(10, DFF, D, -1, 0, WS_W5, 0); DO_W(12, D, 1536, 11, 0, WS_W6, 0); DO_W(14, D, D, 13, 2, WS_W6, 1536);
        DO_W(15, D, D, -1, 0, WS_W8, 0); DO_W(19, D, NUP, 18, 3, WS_W9, 0); DO_W(21, DFF, D, -1, 0, WS_W10, 0);
#undef DO_W
        for (int i = bx * NTHREADS + tid; i < 2 * 3 * NUP; i += G * NTHREADS) { const int layer = i / (3 * NUP), r = i % (3 * NUP), k = r / NUP, cn = r % NUP, pn = cn / 256, half = (cn >> 7) & 1, cc = cn & 127;
            const float* cv = (const float*)args.in[layer == 0 ? 9 : 20]; CWP[i] = cv[k * NUP + half * DFF + 128 * pn + cc]; }
        for (int m = gw * 4; m < MTOK + MMEM; m += NGW * 4) {
            if (m < MTOK) row_prep<4>(x + (size_t)m * D, HB + (size_t)m * D, SSPX + (size_t)m * 16, lane);
            else { const int r = m - MTOK; row_prep<4>(mem + (size_t)r * D, MEMB + (size_t)r * D, SSPM + (size_t)r * 16, lane); }
        }
    }
    SEAM(0);
    if (IN(1)) {
        { pg8::Gemm g{HB, W1, MTOK, NPROJ, D}; pg8::StaticOrder S; S.init(MTOK, NPROJ, G, bx); pg8::EpiScaleBf16 E{PROJ, NPROJ, SSPX};
          pg8::gemm_phase<pg8::EpiScaleBf16, pg8::StaticOrder, true, true>(lds, g, S, E); }
        { pg8::Gemm g{MEMB, WM, MMEM, D, D}; pg8::StaticOrder S; S.init(MMEM, D, G, (bx + 128) % G); pg8::EpiScaleBf16 E{MEMKV, D, SSPM};
          pg8::gemm_phase<pg8::EpiScaleBf16, pg8::StaticOrder, true, true>(lds, g, S, E); }
    }
    SEAM(1);
    if (IN(2)) {
#define P2_DESC(dd, uu) do { const int u_ = (uu); if (u_ >= 4096) { (dd).q = nullptr; } else if (u_ < 3072) { const int bh_ = u_ >> 3, qb_ = ((u_ & 7) + (u_ >> 8)) & 7, b_ = bh_ / 12, h_ = bh_ % 12; \
                const size_t tok_ = (size_t)b_ * SEQ + qb_ * 256 + wave * 32 + (lane & 31); (dd).q = PROJ + tok_ * NPROJ + h_ * 64; (dd).K = PROJ + 768 + h_ * 64; (dd).V = PROJ + 1536 + h_ * 64; (dd).pitch = NPROJ; \
                (dd).tok0 = (long)b_ * SEQ + (qb_ * 4 + 3) * 64; (dd).tstride = 1; (dd).nh = 1; } \
            else { const int v_ = u_ - 3072, b_ = v_ >> 5, hm_ = (v_ >> 3) & 3, qb_ = v_ & 7; const size_t tok_ = (size_t)b_ * SEQ + qb_ * 256 + wave * 32 + (lane & 31); \
                (dd).q = PROJ + tok_ * NPROJ + 2304 + hm_ * 64; (dd).K = MEMKV + hm_ * 64; (dd).V = MEMKV + 256 + hm_ * 64; (dd).pitch = D; (dd).tok0 = (long)b_ * MEML; (dd).tstride = 1; (dd).nh = 1; } } while (0)
        att::TileRegs tr; bf16x8 qf[4]; att::UDesc dn;
        P2_DESC(dn, bx); att::unit_prefetch(tr, qf, dn, tid);
        for (int u = bx; u < 4096; u += G) {
            P2_DESC(dn, u + G);
            if (u < 3072) { const int bh = u >> 3, qb = ((u & 7) + (u >> 8)) & 7; att::sb_unit(lds, tr, qf, dn, PROJ, ATT, bh / 12, bh % 12, qb, tid); }
            else { const int v = u - 3072, b = v >> 5, hm = (v >> 3) & 3, qb = v & 7; const size_t tok = (size_t)b * SEQ + qb * 256 + wave * 32 + (lane & 31);
                att::sm_unit<1, false>(lds, tr, qf, dn, MEMKV + hm * 64, MEMKV + 256 + hm * 64, D, (long)b * MEML, 1, 0, 0, 0.f, ATT + tok * D + 768 + hm * 64, nullptr, tid); }
        }
#undef P2_DESC
    }
    SEAM(2);
    if (IN(3)) { pg8::Gemm g{ATT, W3, MTOK, D, D}; pg8::StaticOrder S; S.init(MTOK, D, G, bx); pg8::EpiResid E{HB, HB, nullptr, SSP1};
        pg8::gemm_phase<pg8::EpiResid, pg8::StaticOrder, true, true>(lds, g, S, E); }
    SEAM(3);
    if (IN(4)) { pg8::Gemm g{HB, W4, MTOK, NUP, D}; pg8::StaticOrder S; S.init(MTOK, NUP, G, bx); pg8::EpiConvGate E{ACT, SSP1, CWP, SIDE, (PG8_LAS pg8::f32x4*)(lds + LDS_X_OFF)};
        pg8::gemm_phase<pg8::EpiConvGate, pg8::StaticOrder, true, true>(lds, g, S, E); }
    SEAM(4);
#define FIXUP(cwl) do { const float* cw_ = (cwl); \
        for (int i = bx * NTHREADS + tid; i < 256 * 2 * (DFF / 4); i += G * NTHREADS) { const int pm = i / (2 * (DFF / 4)), r = i % (2 * (DFF / 4)), t = r / (DFF / 4), j = (r % (DFF / 4)) * 4, cn = 256 * (j >> 7) + (j & 127); \
            f32x4 c2[2]; \
            _Pragma("unroll") for (int hf = 0; hf < 2; ++hf) { const int c = cn + 128 * hf; const float* sd = SIDE + (size_t)pm * 4 * NUP + c; \
                const f32x4 u0 = *(const f32x4*)sd, u1 = *(const f32x4*)(sd + NUP); f32x4 um1 = {0.f, 0.f, 0.f, 0.f}, um2 = {0.f, 0.f, 0.f, 0.f}; if (pm & 7) { um2 = *(const f32x4*)(sd - 2 * NUP); um1 = *(const f32x4*)(sd - NUP); } \
                const f32x4 w0 = *(const f32x4*)(cw_ + c), w1 = *(const f32x4*)(cw_ + NUP + c), w2 = *(const f32x4*)(cw_ + 2 * NUP + c); \
                c2[hf] = (t == 0) ? (w2 * u0 + w1 * um1 + w0 * um2) : (w2 * u1 + w1 * u0 + w0 * um1); } \
            f32x4 o_; \
            _Pragma("unroll") for (int e = 0; e < 4; ++e) { const float g = c2[1][e], sg = g * __builtin_amdgcn_rcpf(1.f + ex2(-LOG2E * g)); o_[e] = c2[0][e] * sg; } \
            u32x2 pk; pk.x = cvtpk(o_[0], o_[1]); pk.y = cvtpk(o_[2], o_[3]); *(u32x2*)(ACT + (size_t)(pm * 256 + t) * DFF + j) = pk; } } while (0)
    if (IN(5)) FIXUP(CWP);
    SEAM(5);
    if (IN(6)) { pg8::Gemm g{ACT, W5, MTOK, D, DFF}; pg8::StaticOrder S; S.init(MTOK, D, G, bx); pg8::EpiResid E{HB, HB, nullptr, SSP2};
        pg8::gemm_phase<pg8::EpiResid, pg8::StaticOrder, true, true>(lds, g, S, E); }
    SEAM(6);
    if (IN(7)) { pg8::Gemm g{HB, W6, MTOK, NPROJ, D}; pg8::StaticOrder S; S.init(MTOK, NPROJ, G, bx); pg8::EpiScaleBf16 E{PROJ, NPROJ, SSP2};
        pg8::gemm_phase<pg8::EpiScaleBf16, pg8::StaticOrder, true, true>(lds, g, S, E); }
    SEAM(7);
    if (IN(8)) {
#define P8_DEC(uu) const int hp_ = (uu) & 1, rn_ = ((uu) >> 1) & 15, g_ = ((uu) >> 5) % 3, b_ = (uu) / 96; \
            const int d_ = (g_ == 0) ? 1 : (g_ == 1) ? 4 : 16, res_ = (g_ == 0) ? 0 : (g_ == 1) ? (rn_ >> 2) : rn_, n_ = (g_ == 0) ? rn_ : (g_ == 1) ? (rn_ & 3) : 0; \
            const int head_ = g_ * 4 + hp_ * 2 + (wave >> 2), i_ = (wave & 3) * 32 + (lane & 31), jt0_ = (n_ == 0) ? 2 : 0; \
            const size_t tok_ = (size_t)b_ * SEQ + (size_t)(n_ * 128 + i_) * d_ + res_; const long ktok0_ = (long)b_ * SEQ + (long)(n_ - 1) * 128 * d_ + res_; \
            const bf16* Kp_ = PROJ + (g_ * 4 + hp_ * 2) * 64; const bf16* Vp_ = Kp_ + 768;
#define P8_DESC(dd, uu) do { const int u_ = (uu); if (u_ >= 4096) { (dd).q = nullptr; } else if (u_ < 3072) { P8_DEC(u_) \
                (dd).q = PROJ + tok_ * NPROJ + 1536 + head_ * 64; (dd).K = Kp_; (dd).V = Vp_; (dd).pitch = NPROJ; (dd).tok0 = ktok0_ + (long)jt0_ * 64 * d_; (dd).tstride = d_; (dd).nh = 2; } \
            else { const int v_ = u_ - 3072, b_ = v_ >> 5, hm_ = (v_ >> 3) & 3, qb_ = v_ & 7; const size_t tok_ = (size_t)b_ * SEQ + qb_ * 256 + wave * 32 + (lane & 31); \
                (dd).q = PROJ + tok_ * NPROJ + 2304 + hm_ * 64; (dd).K = MEMKV + 512 + hm_ * 64; (dd).V = MEMKV + 768 + hm_ * 64; (dd).pitch = D; (dd).tok0 = (long)b_ * MEML; (dd).tstride = 1; (dd).nh = 1; } } while (0)
        att::TileRegs tr; bf16x8 qf[4]; att::UDesc dn;
        P8_DESC(dn, bx); att::unit_prefetch(tr, qf, dn, tid);
        for (int u = bx; u < 4096; u += G) {
            P8_DESC(dn, u + G);
            if (u < 3072) { P8_DEC(u)
                const float slope2d = ex2(-8.f * (float)(head_ + 1) / 12.f) * LOG2E * (float)d_;
                att::sm_unit<2, true>(lds, tr, qf, dn, Kp_, Vp_, NPROJ, ktok0_, d_, jt0_, i_, slope2d, ATT + tok_ * D + head_ * 64, LSE + tok_ * 12 + head_, tid); }
            else { const int v = u - 3072, b = v >> 5, hm = (v >> 3) & 3, qb = v & 7; const size_t tok = (size_t)b * SEQ + qb * 256 + wave * 32 + (lane & 31);
                att::sm_unit<1, false>(lds, tr, qf, dn, MEMKV + 512 + hm * 64, MEMKV + 768 + hm * 64, D, (long)b * MEML, 1, 0, 0, 0.f, ATT + tok * D + 768 + hm * 64, nullptr, tid); }
        }
#undef P8_DESC
#undef P8_DEC
    }
    SEAM(8);
    if (IN(9)) {
        for (int i0 = bx * NTHREADS + tid; i0 < MTOK * 96; i0 += 4 * G * NTHREADS) {
            u32x4 v[4]; float al[4];
#pragma unroll
            for (int k = 0; k < 4; ++k) { const int i = i0 + k * G * NTHREADS; if (i < MTOK * 96) v[k] = *(const u32x4*)(ATT + (size_t)(i / 96) * D + (i % 96) * 8); }
#pragma unroll
            for (int k = 0; k < 4; ++k) { const int i = i0 + k * G * NTHREADS; al[k] = 0.f; if (i < MTOK * 96) { const int row = i / 96, head = (i % 96) >> 3, hg = head & 3;
                const float* ls = LSE + (size_t)row * 12 + hg; const float l0 = ls[0], l1 = ls[4], l2 = ls[8], mx = __builtin_fmaxf(l0, __builtin_fmaxf(l1, l2));
                const float e0 = ex2(l0 - mx), e1 = ex2(l1 - mx), e2 = ex2(l2 - mx); const float mine = (head < 4) ? e0 : (head < 8) ? e1 : e2; al[k] = mine * __builtin_amdgcn_rcpf(e0 + e1 + e2); } }
#pragma unroll
            for (int k = 0; k < 4; ++k) { const int i = i0 + k * G * NTHREADS; if (i < MTOK * 96) { u32x4 w = v[k];
#pragma unroll
                for (int e = 0; e < 4; ++e) { const float a = __uint_as_float(w[e] << 16) * al[k], b2 = __uint_as_float(w[e] & 0xffff0000u) * al[k]; w[e] = cvtpk(a, b2); }
                *(u32x4*)(ATT + (size_t)(i / 96) * D + (i % 96) * 8) = w; } }
        }
    }
    SEAM(9);
    if (IN(10)) { pg8::Gemm g{ATT, W8, MTOK, D, D}; pg8::StaticOrder S; S.init(MTOK, D, G, bx); pg8::EpiResid E{HB, HB, nullptr, SSP3};
        pg8::gemm_phase<pg8::EpiResid, pg8::StaticOrder, true, true>(lds, g, S, E); }
    SEAM(10);
    if (IN(11)) { pg8::Gemm g{HB, W9, MTOK, NUP, D}; pg8::StaticOrder S; S.init(MTOK, NUP, G, bx); pg8::EpiConvGate E{ACT, SSP3, CWP + 3 * NUP, SIDE, (PG8_LAS pg8::f32x4*)(lds + LDS_X_OFF)};
        pg8::gemm_phase<pg8::EpiConvGate, pg8::StaticOrder, true, true>(lds, g, S, E); }
    SEAM(11);
    if (IN(12)) FIXUP(CWP + 3 * NUP);
    SEAM(12);
    if (IN(13)) { pg8::Gemm g{ACT, W10, MTOK, D, DFF}; pg8::StaticOrder S; S.init(MTOK, D, G, bx); pg8::EpiResid E{HB, HB, nullptr, SSP4};
        pg8::gemm_phase<pg8::EpiResid, pg8::StaticOrder, true, true>(lds, g, S, E); }
    SEAM(13);
    if (IN(14)) {
        const float* fn = (const float*)args.in[22];
        const f32x4* gp = (const f32x4*)fn;
        for (int m0 = gw * 4; m0 < MTOK; m0 += NGW * 4) {
            u32x4 b[4][2]; float rs[4];
#pragma unroll
            for (int r = 0; r < 4; ++r) { const u32x4* hp = (const u32x4*)(HB + (size_t)(m0 + r) * D) + lane; b[r][0] = __builtin_nontemporal_load(hp); b[r][1] = __builtin_nontemporal_load(hp + 64); }
#pragma unroll
            for (int r = 0; r < 4; ++r) rs[r] = pg8::row_rstd(SSP4, m0 + r);
#pragma unroll
            for (int r = 0; r < 4; ++r) { f32x4* o = (f32x4*)(out + (size_t)(m0 + r) * D);
#pragma unroll
                for (int j = 0; j < 2; ++j) { const u32x4 bb = b[r][j]; const int c4 = (64 * j + lane) * 2; const f32x4 g0 = gp[c4], g1 = gp[c4 + 1]; f32x4 v0, v1;
                    v0[0] = __uint_as_float(bb.x << 16); v0[1] = __uint_as_float(bb.x & 0xffff0000u); v0[2] = __uint_as_float(bb.y << 16); v0[3] = __uint_as_float(bb.y & 0xffff0000u);
                    v1[0] = __uint_as_float(bb.z << 16); v1[1] = __uint_as_float(bb.z & 0xffff0000u); v1[2] = __uint_as_float(bb.w << 16); v1[3] = __uint_as_float(bb.w & 0xffff0000u);
                    __builtin_nontemporal_store(v0 * rs[r] * g0, o + c4); __builtin_nontemporal_store(v1 * rs[r] * g1, o + c4 + 1); } } }
    }
#undef IN
#undef SEAM
#undef FIXUP
}

extern "C" void kernel_launch(void* const* d_in, const int* in_sizes, int n_in, void* d_out, int out_size, void* d_ws, size_t ws_size, hipStream_t stream) {
    static int grid = 0;
    if (grid == 0) {
        if (n_in != 23 || in_sizes[0] != MTOK * D || out_size != MTOK * D || ws_size < WS_END) { fprintf(stderr, "kernel_launch: unexpected shapes (n_in %d, in0 %d, out %d, ws %zu)\n", n_in, n_in > 0 ? in_sizes[0] : -1, out_size, ws_size); grid = -1; return; }
        int dev = 0, cus = 0, per_cu = 0;
        if (hipGetDevice(&dev) != hipSuccess || hipDeviceGetAttribute(&cus, hipDeviceAttributeMultiprocessorCount, dev) != hipSuccess) { grid = -1; return; }
        if (hipFuncSetAttribute((const void*)yoco_fwd, hipFuncAttributeMaxDynamicSharedMemorySize, LDS_BYTES) != hipSuccess) { fprintf(stderr, "kernel_launch: hipFuncSetAttribute failed\n"); grid = -1; return; }
        if (hipOccupancyMaxActiveBlocksPerMultiprocessor(&per_cu, (const void*)yoco_fwd, NTHREADS, LDS_BYTES) != hipSuccess || per_cu < 1) { fprintf(stderr, "kernel_launch: occupancy query gave %d\n", per_cu); per_cu = 1; }
        (void)hipGetLastError();
        grid = cus * per_cu;
    }
    if (grid < 0) return;
    if (hipMemsetAsync((char*)d_ws + WS_CTL, 0, CTL_BYTES, stream) != hipSuccess) { fprintf(stderr, "kernel_launch: memset of barrier words failed\n"); return; }
    Args a{};
    for (int i = 0; i < 23; ++i) a.in[i] = d_in[i];
    a.out = (float*)d_out; a.ws = (unsigned char*)d_ws;
#if MK_ONE_LAUNCH
    a.ph_lo = 0; a.ph_hi = N_PHASES;
    void* kargs[] = {&a};
    hipError_t e = hipLaunchCooperativeKernel((const void*)yoco_fwd, dim3(grid), dim3(NTHREADS), kargs, LDS_BYTES, stream);
    if (e != hipSuccess) fprintf(stderr, "kernel_launch: cooperative launch failed: %s (grid %d)\n", hipGetErrorString(e), grid);
#else
    for (int p = 0; p < N_PHASES; ++p) { a.ph_lo = p; a.ph_hi = p + 1; const int reps = ((REP_MASK >> p) & 1) ? 2 : 1;
        for (int r = 0; r < reps; ++r) { a.flags = (r + 1 < reps) ? PROBE_FLAGS : 0; hipLaunchKernelGGL(yoco_fwd, dim3(grid), dim3(NTHREADS), LDS_BYTES, stream, a); } }
#endif
}
```
